# Optimizing an MI355X kernel written in HIP

```python
import jax, jax.numpy as jnp
from jax import lax
import numpy as np

D_MODEL = 1024
BATCH = 4
SEQ = 4096
DEPTH = 1
DEC_BATCH = 32
DEC_SEQ = 4
PAST_LEN = 8192
PAGE_SIZE = 128

HEAD_DIM = 64
N_HEADS = 8
KV_HEADS = 2
HPG = N_HEADS // KV_HEADS
ATTN_WIDTH = N_HEADS * HEAD_DIM
KV_WIDTH = KV_HEADS * HEAD_DIM
ROT_DIM = HEAD_DIM // 4
ROT_HALF = ROT_DIM // 2
ROPE_THETA = 500000.0
CMP_BLOCK = 32
CMP_STRIDE = 16
CMP_HIDDEN = 128
SEL_BLOCK = 64
TOP_N = 16
N_INIT_BLOCKS = 1
N_LOCAL_BLOCKS = 2
WINDOW = 512
QBLK = 128
GMLP_GROUPS = 4
CHUNK = 128
GMLP_GROUP_WIDTH = 128
GMLP_WIDTH = GMLP_GROUPS * GMLP_GROUP_WIDTH
N_BRANCH = 2
IN_WIDTH = ATTN_WIDTH + 6 * KV_WIDTH + 3 * N_HEADS + ATTN_WIDTH + 3 * GMLP_WIDTH + N_BRANCH * D_MODEL
NEG = -1e30
BIG = 1e30
EPS = 1e-6

kernel_name = 'nsa_gmlp_gated_hybrid_step'


def rmsnorm(x, g):
    xf = x.astype(jnp.float32)
    r = lax.rsqrt(jnp.mean(xf * xf, axis=-1, keepdims=True) + EPS)
    return (xf * r).astype(x.dtype) * g


def layernorm(x, g, b):
    xf = x.astype(jnp.float32)
    mu = jnp.mean(xf, axis=-1, keepdims=True)
    var = jnp.mean(jnp.square(xf - mu), axis=-1, keepdims=True)
    return ((xf - mu) * lax.rsqrt(var + EPS)).astype(x.dtype) * g + b


def rope(x, pos):
    inv = jnp.power(jnp.float32(ROPE_THETA), -jnp.arange(0, ROT_DIM, 2, dtype=jnp.float32) / ROT_DIM)
    ang = pos.astype(jnp.float32)[:, None] * inv[None, :]
    cos = jnp.cos(ang)[None, :, None, :].astype(x.dtype)
    sin = jnp.sin(ang)[None, :, None, :].astype(x.dtype)
    x1, x2, xr = x[..., :ROT_HALF], x[..., ROT_HALF:ROT_DIM], x[..., ROT_DIM:]
    return jnp.concatenate([x1 * cos - x2 * sin, x2 * cos + x1 * sin, xr], axis=-1)


def masked_softmax(s, mask):
    s = jnp.where(mask, s.astype(jnp.float32), NEG)
    return jnp.where(mask, jax.nn.softmax(s, axis=-1), 0.0)


def compress(rows, params):
    w1, b1, w2, b2 = params
    B, T, G, dh = rows.shape
    n_cmp = (T - CMP_BLOCK) // CMP_STRIDE + 1
    idx = jnp.arange(n_cmp)[:, None] * CMP_STRIDE + jnp.arange(CMP_BLOCK)[None, :]
    blocks = rows[:, idx].transpose(0, 1, 3, 2, 4).reshape(B, n_cmp, G, CMP_BLOCK * dh)
    return jax.nn.gelu(blocks @ w1 + b1) @ w2 + b2


def cmp_end_positions(n_cmp):
    return jnp.arange(n_cmp) * CMP_STRIDE + CMP_BLOCK - 1


def cmp_sel_overlap(n_cmp, n_sel):
    cs = jnp.arange(n_cmp)[:, None] * CMP_STRIDE
    ss = jnp.arange(n_sel)[None, :] * SEL_BLOCK
    ov = jnp.minimum(cs + CMP_BLOCK, ss + SEL_BLOCK) - jnp.maximum(cs, ss)
    return jnp.clip(ov, 0, None).astype(jnp.float32) / CMP_BLOCK


def nsa_core(q, qpos, kc, vc, cend, overlap, gather_sel, kw, vw, kpos):
    B, Tq, H, dh = q.shape
    q5 = q.reshape(B, Tq, KV_HEADS, HPG, dh) * (dh ** -0.5)
    s = jnp.einsum('bqgjd,bcgd->bgjqc', q5, kc)
    p = masked_softmax(s, (cend[None, :] <= qpos[:, None])[None, None, None])
    o_cmp = jnp.einsum('bgjqc,bcgd->bqgjd', p.astype(vc.dtype), vc).reshape(B, Tq, H, dh)
    imp = jnp.einsum('bgjqc,cs->bgqs', p, overlap)
    n_sel = overlap.shape[1]
    blk = jnp.arange(n_sel)[None, :]
    cur = (qpos // SEL_BLOCK)[:, None]
    valid = blk <= cur
    forced = ((blk <= cur) & (blk > cur - N_LOCAL_BLOCKS)) | (blk < N_INIT_BLOCKS)
    score = jnp.where(forced, BIG, jnp.where(valid, imp, NEG))
    _, idx = lax.top_k(score, min(TOP_N, n_sel))
    kg, vg = gather_sel(idx)
    n_top = idx.shape[-1]
    key_pos = idx[..., None] * SEL_BLOCK + jnp.arange(SEL_BLOCK)
    msel = (key_pos <= qpos[None, None, :, None, None]).reshape(B, KV_HEADS, 1, Tq, n_top * SEL_BLOCK)
    s = jnp.einsum('bqgjd,bgqnkd->bgjqnk', q5, kg).reshape(B, KV_HEADS, HPG, Tq, n_top * SEL_BLOCK)
    p = masked_softmax(s, msel)
    o_sel = jnp.einsum('bgjqm,bgqmd->bqgjd', p.astype(vg.dtype), vg.reshape(B, KV_HEADS, Tq, n_top * SEL_BLOCK, dh)).reshape(B, Tq, H, dh)
    s = jnp.einsum('bqgjd,bkgd->bgjqk', q5, kw)
    mw = (kpos[None, :] <= qpos[:, None]) & (kpos[None, :] > qpos[:, None] - WINDOW) & (kpos[None, :] >= 0)
    p = masked_softmax(s, mw[None, None, None])
    o_win = jnp.einsum('bgjqk,bkgd->bqgjd', p.astype(vw.dtype), vw).reshape(B, Tq, H, dh)
    return o_cmp, o_sel, o_win


def in_project(x, pos, lw):
    B, T, _ = x.shape
    h = rmsnorm(x, lw['norm_g'])
    proj = h @ lw['w_in']
    sizes = [ATTN_WIDTH] + [KV_WIDTH] * 6 + [3 * N_HEADS, ATTN_WIDTH, GMLP_WIDTH, GMLP_WIDTH, GMLP_WIDTH, N_BRANCH * D_MODEL]
    offs = np.cumsum(sizes)[:-1].tolist()
    q, k_cmp, v_cmp, k_sel, v_sel, k_win, v_win, gl, za, u, v, zb, r = jnp.split(proj, offs, axis=-1)
    kvh = lambda t: t.reshape(B, T, KV_HEADS, HEAD_DIM)
    q = rope(q.reshape(B, T, N_HEADS, HEAD_DIM), pos)
    return (q, kvh(k_cmp), kvh(v_cmp), rope(kvh(k_sel), pos), kvh(v_sel), rope(kvh(k_win), pos), kvh(v_win), gl, za, u, v, zb, r)


def spatial_gate(v, w_s, b_s):
    B, T, _ = v.shape
    n_chunk = -(-T // CHUNK)
    v = jnp.pad(v, ((0, 0), (0, n_chunk * CHUNK - T), (0, 0))).reshape(B, n_chunk, CHUNK, GMLP_GROUPS, GMLP_GROUP_WIDTH)
    tri = jnp.tril(jnp.ones((CHUNK, CHUNK), dtype=bool))
    w = jnp.where(tri[None], w_s, 0.0).astype(v.dtype)
    out = jnp.einsum('gts,bcsgd->bctgd', w, v) + b_s.T[None, None, :, :, None].astype(v.dtype)
    return out.reshape(B, n_chunk * CHUNK, GMLP_WIDTH)[:, :T]


def mixer_out(x, o_cmp, o_sel, o_win, gl, za, u, v, zb, r, lw):
    B, T, _ = x.shape
    g = jax.nn.sigmoid(gl.astype(jnp.float32)).astype(x.dtype).reshape(B, T, N_HEADS, 3)
    o = g[..., 0:1] * o_cmp + g[..., 1:2] * o_sel + g[..., 2:3] * o_win
    pa = (o.reshape(B, T, ATTN_WIDTH) * jax.nn.silu(za)) @ lw['w_pa']
    v_n = layernorm(jax.nn.gelu(v), lw['v_norm_g'], lw['v_norm_b'])
    sgu = jax.nn.gelu(u) * spatial_gate(v_n, lw['w_spatial'], lw['b_spatial'])
    pb = (sgu * jax.nn.silu(zb)) @ lw['w_pb']
    ra, rb = jnp.split(r, 2, axis=-1)
    merged = jax.nn.sigmoid(ra) * pa + jax.nn.sigmoid(rb) * pb
    return x + merged @ lw['w_o'], v_n


def prompt_layer(x, lw):
    B, S, _ = x.shape
    pos = jnp.arange(S)
    q, k_cmp, v_cmp, k_sel, v_sel, k_win, v_win, gl, za, u, v, zb, r = in_project(x, pos, lw)
    kc = compress(k_cmp, lw['cmp_k'])
    n_cmp = kc.shape[1]
    cend = cmp_end_positions(n_cmp)
    kc = rope(kc, cend)
    vc = compress(v_cmp, lw['cmp_v'])
    n_sel = S // SEL_BLOCK
    overlap = cmp_sel_overlap(n_cmp, n_sel)
    k_sel_t = k_sel.reshape(B, n_sel, SEL_BLOCK, KV_HEADS, HEAD_DIM).transpose(0, 3, 1, 2, 4)
    v_sel_t = v_sel.reshape(B, n_sel, SEL_BLOCK, KV_HEADS, HEAD_DIM).transpose(0, 3, 1, 2, 4)
    bidx = jnp.arange(B)[:, None, None, None]
    gidx = jnp.arange(KV_HEADS)[None, :, None, None]

    def gather_sel(idx):
        return k_sel_t[bidx, gidx, idx], v_sel_t[bidx, gidx, idx]

    pad = ((0, 0), (WINDOW, 0), (0, 0), (0, 0))
    kw_pad, vw_pad = jnp.pad(k_win, pad), jnp.pad(v_win, pad)
    n_qb = S // QBLK
    q_blocks = q.reshape(B, n_qb, QBLK, N_HEADS, HEAD_DIM).transpose(1, 0, 2, 3, 4)

    def block_fn(args):
        i, qb = args
        start = i * QBLK
        qpos = start + jnp.arange(QBLK)
        kw = lax.dynamic_slice_in_dim(kw_pad, start, WINDOW + QBLK, axis=1)
        vw = lax.dynamic_slice_in_dim(vw_pad, start, WINDOW + QBLK, axis=1)
        kpos = start - WINDOW + jnp.arange(WINDOW + QBLK)
        return nsa_core(qb, qpos, kc, vc, cend, overlap, gather_sel, kw, vw, kpos)

    o_blocks = lax.map(block_fn, (jnp.arange(n_qb), q_blocks))
    o_cmp, o_sel, o_win = [t.transpose(1, 0, 2, 3, 4).reshape(B, S, N_HEADS, HEAD_DIM) for t in o_blocks]
    x_new, _ = mixer_out(x, o_cmp, o_sel, o_win, gl, za, u, v, zb, r, lw)
    wc = min(WINDOW, S)
    return x_new, (k_cmp, v_cmp, k_sel, v_sel, k_win[:, S - wc:], v_win[:, S - wc:])


def sample_layer(x, ck_cmp, cv_cmp, ck_sel, cv_sel, ck_win, cv_win, page_table, lw):
    Bd, Tn, _ = x.shape
    n_pages = page_table.shape[1]
    past = n_pages * PAGE_SIZE
    pos = past + jnp.arange(Tn)
    q, k_cmp, v_cmp, k_sel, v_sel, k_win, v_win, gl, za, u, v, zb, r = in_project(x, pos, lw)

    def gather_pages(pool):
        return pool[page_table].reshape(Bd, past, KV_HEADS, HEAD_DIM)

    kc = compress(jnp.concatenate([gather_pages(ck_cmp), k_cmp], axis=1), lw['cmp_k'])
    n_cmp = kc.shape[1]
    cend = cmp_end_positions(n_cmp)
    kc = rope(kc, cend)
    vc = compress(jnp.concatenate([gather_pages(cv_cmp), v_cmp], axis=1), lw['cmp_v'])
    n_past_blk = past // SEL_BLOCK
    n_tail = -(-Tn // SEL_BLOCK)
    overlap = cmp_sel_overlap(n_cmp, n_past_blk + n_tail)
    bpp = PAGE_SIZE // SEL_BLOCK
    pk = ck_sel.reshape(-1, bpp, SEL_BLOCK, KV_HEADS, HEAD_DIM)
    pv = cv_sel.reshape(-1, bpp, SEL_BLOCK, KV_HEADS, HEAD_DIM)
    tpad = ((0, 0), (0, n_tail * SEL_BLOCK - Tn), (0, 0), (0, 0))
    tk = jnp.pad(k_sel, tpad).reshape(Bd, n_tail, SEL_BLOCK, KV_HEADS, HEAD_DIM).transpose(0, 3, 1, 2, 4)
    tv = jnp.pad(v_sel, tpad).reshape(Bd, n_tail, SEL_BLOCK, KV_HEADS, HEAD_DIM).transpose(0, 3, 1, 2, 4)
    bidx = jnp.arange(Bd)[:, None, None, None]
    gidx = jnp.arange(KV_HEADS)[None, :, None, None]

    def gather_sel(idx):
        phys = page_table[bidx, jnp.minimum(idx // bpp, n_pages - 1)]
        sub = idx % bpp
        ti = jnp.clip(idx - n_past_blk, 0, n_tail - 1)
        is_tail = (idx >= n_past_blk)[..., None, None]
        kg = jnp.where(is_tail, tk[bidx, gidx, ti], pk[phys, sub, :, gidx])
        vg = jnp.where(is_tail, tv[bidx, gidx, ti], pv[phys, sub, :, gidx])
        return kg, vg

    wc = ck_win.shape[1]
    kw = jnp.concatenate([ck_win, k_win], axis=1)
    vw = jnp.concatenate([cv_win, v_win], axis=1)
    kpos = past - wc + jnp.arange(wc + Tn)
    o_cmp, o_sel, o_win = nsa_core(q, pos, kc, vc, cend, overlap, gather_sel, kw, vw, kpos)
    x_new, v_n = mixer_out(x, o_cmp, o_sel, o_win, gl, za, u, v, zb, r, lw)
    return x_new, (k_cmp, v_cmp, k_sel, v_sel, kw[:, kw.shape[1] - wc:], vw[:, vw.shape[1] - wc:], v_n)


def setup_inputs(seed: int = 0) -> dict:
    key = jax.random.key(seed)
    ks = jax.random.split(key, 32)
    f32 = jnp.float32
    nrm = lambda k, shape, scale: scale * jax.random.normal(k, shape, f32)
    n_pages = PAST_LEN // PAGE_SIZE
    n_used = DEC_BATCH * n_pages
    n_phys = n_used + max(1, n_used // 4)
    win_cache = min(WINDOW, PAST_LEN)
    pool_shape = (DEPTH, n_phys, PAGE_SIZE, KV_HEADS, HEAD_DIM)
    win_shape = (DEPTH, DEC_BATCH, win_cache, KV_HEADS, HEAD_DIM)
    perm = jax.random.permutation(ks[8], n_phys)
    page_table = perm[:n_used].reshape(DEC_BATCH, n_pages).astype(jnp.int32)
    L = DEPTH
    return {
        'x_prompt': nrm(ks[0], (BATCH, SEQ, D_MODEL), 1.0),
        'x_sample': nrm(ks[1], (DEC_BATCH, DEC_SEQ, D_MODEL), 1.0),
        'cache_k_cmp': nrm(ks[2], pool_shape, 1.0),
        'cache_v_cmp': nrm(ks[3], pool_shape, 1.0),
        'cache_k_sel': nrm(ks[4], pool_shape, 1.0),
        'cache_v_sel': nrm(ks[5], pool_shape, 1.0),
        'cache_k_win': nrm(ks[6], win_shape, 1.0),
        'cache_v_win': nrm(ks[7], win_shape, 1.0),
        'page_table': page_table,
        'norm_g': 1.0 + nrm(ks[9], (L, D_MODEL), 0.1),
        'w_in': nrm(ks[10], (L, D_MODEL, IN_WIDTH), D_MODEL ** -0.5),
        'cmp_k_w1': nrm(ks[11], (L, CMP_BLOCK * HEAD_DIM, CMP_HIDDEN), (CMP_BLOCK * HEAD_DIM) ** -0.5),
        'cmp_k_b1': nrm(ks[12], (L, CMP_HIDDEN), 0.02),
        'cmp_k_w2': nrm(ks[13], (L, CMP_HIDDEN, HEAD_DIM), CMP_HIDDEN ** -0.5),
        'cmp_k_b2': nrm(ks[14], (L, HEAD_DIM), 0.02),
        'cmp_v_w1': nrm(ks[15], (L, CMP_BLOCK * HEAD_DIM, CMP_HIDDEN), (CMP_BLOCK * HEAD_DIM) ** -0.5),
        'cmp_v_b1': nrm(ks[16], (L, CMP_HIDDEN), 0.02),
        'cmp_v_w2': nrm(ks[17], (L, CMP_HIDDEN, HEAD_DIM), CMP_HIDDEN ** -0.5),
        'cmp_v_b2': nrm(ks[18], (L, HEAD_DIM), 0.02),
        'v_norm_g': 1.0 + nrm(ks[19], (L, GMLP_WIDTH), 0.1),
        'v_norm_b': nrm(ks[20], (L, GMLP_WIDTH), 0.02),
        'w_spatial': nrm(ks[21], (L, GMLP_GROUPS, CHUNK, CHUNK), CHUNK ** -0.5),
        'b_spatial': 1.0 + nrm(ks[22], (L, GMLP_GROUPS, CHUNK), 0.1),
        'w_pa': nrm(ks[23], (L, ATTN_WIDTH, D_MODEL), ATTN_WIDTH ** -0.5),
        'w_pb': nrm(ks[24], (L, GMLP_WIDTH, D_MODEL), GMLP_WIDTH ** -0.5),
        'w_o': nrm(ks[25], (L, D_MODEL, D_MODEL), D_MODEL ** -0.5),
        'final_g': 1.0 + nrm(ks[26], (D_MODEL,), 0.1),
    }


def reference(x_prompt, x_sample, cache_k_cmp, cache_v_cmp, cache_k_sel, cache_v_sel, cache_k_win, cache_v_win, page_table,
              norm_g, w_in, cmp_k_w1, cmp_k_b1, cmp_k_w2, cmp_k_b2, cmp_v_w1, cmp_v_b1, cmp_v_w2, cmp_v_b2,
              v_norm_g, v_norm_b, w_spatial, b_spatial, w_pa, w_pb, w_o, final_g):
    hp, hs = x_prompt, x_sample
    st_p = [[] for _ in range(6)]
    st_s = [[] for _ in range(7)]
    for l in range(DEPTH):
        lw = {
            'norm_g': norm_g[l], 'w_in': w_in[l],
            'cmp_k': (cmp_k_w1[l], cmp_k_b1[l], cmp_k_w2[l], cmp_k_b2[l]),
            'cmp_v': (cmp_v_w1[l], cmp_v_b1[l], cmp_v_w2[l], cmp_v_b2[l]),
            'v_norm_g': v_norm_g[l], 'v_norm_b': v_norm_b[l],
            'w_spatial': w_spatial[l], 'b_spatial': b_spatial[l],
            'w_pa': w_pa[l], 'w_pb': w_pb[l], 'w_o': w_o[l],
        }
        hp, sp = prompt_layer(hp, lw)
        hs, ss = sample_layer(hs, cache_k_cmp[l], cache_v_cmp[l], cache_k_sel[l], cache_v_sel[l],
                              cache_k_win[l], cache_v_win[l], page_table, lw)
        for lst, t in zip(st_p, sp):
            lst.append(t)
        for lst, t in zip(st_s, ss):
            lst.append(t)
    y_prompt = rmsnorm(hp, final_g)
    y_sample = rmsnorm(hs, final_g)
    p_k_cmp, p_v_cmp, p_k_sel, p_v_sel, p_k_win, p_v_win = [jnp.stack(t) for t in st_p]
    s_k_cmp, s_v_cmp, s_k_sel, s_v_sel, s_k_win, s_v_win, s_v_chunk = [jnp.stack(t) for t in st_s]
    return (y_prompt, y_sample, p_k_cmp, p_v_cmp, p_k_sel, p_v_sel, p_k_win, p_v_win,
            s_k_cmp, s_v_cmp, s_k_sel, s_v_sel, s_k_win, s_v_win, s_v_chunk)
```

```cpp
#include <hip/hip_runtime.h>
#include <hip/hip_cooperative_groups.h>
#include <cstdint>
#include <cstdio>
namespace cg = cooperative_groups;

#ifndef ONE_LAUNCH
#define ONE_LAUNCH 1
#endif

constexpr int D_MODEL = 1024, BATCH = 4, SEQ = 4096, DEC_BATCH = 32, DEC_SEQ = 4, PAST_LEN = 8192;
constexpr int HEAD_DIM = 64, HPG = 4;
constexpr int IN_WIDTH = 5400;
constexpr int MP = BATCH * SEQ;
constexpr int MS = DEC_BATCH * DEC_SEQ;
constexpr int MT = MP + MS;
constexpr int N_PAGES = 64;
constexpr int NCMP_P = 255, NCMP_S = 511;
constexpr int NSEL_P = 64, NSEL_S = 129;
constexpr int WINDOW = 512;
constexpr int C_Q = 0, C_KC = 512, C_VC = 640, C_KS = 768, C_VS = 896, C_KW = 1024, C_VW = 1152, C_GL = 1280,
              C_ZA = 1304, C_U = 1816, C_V = 2328, C_ZB = 2840, C_RA = 3352, C_RB = 4376;
constexpr size_t O_YP = 0;
constexpr size_t O_YS = O_YP + (size_t)MP * 1024;
constexpr size_t O_PKC = O_YS + (size_t)MS * 1024;
constexpr size_t O_PVC = O_PKC + (size_t)MP * 128;
constexpr size_t O_PKS = O_PVC + (size_t)MP * 128;
constexpr size_t O_PVS = O_PKS + (size_t)MP * 128;
constexpr size_t O_PKW = O_PVS + (size_t)MP * 128;
constexpr size_t O_PVW = O_PKW + (size_t)BATCH * 512 * 128;
constexpr size_t O_SKC = O_PVW + (size_t)BATCH * 512 * 128;
constexpr size_t O_SVC = O_SKC + (size_t)MS * 128;
constexpr size_t O_SKS = O_SVC + (size_t)MS * 128;
constexpr size_t O_SVS = O_SKS + (size_t)MS * 128;
constexpr size_t O_SKW = O_SVS + (size_t)MS * 128;
constexpr size_t O_SVW = O_SKW + (size_t)DEC_BATCH * 512 * 128;
constexpr size_t O_SVCH = O_SVW + (size_t)DEC_BATCH * 512 * 128;
constexpr size_t O_TOTAL = O_SVCH + (size_t)MS * 512;
static_assert(O_TOTAL == 30146560, "output size");

constexpr int ROPE_NPOS = 8200;

struct Params {
    const float* x_prompt; const float* x_sample;
    const float* ck_cmp; const float* cv_cmp; const float* ck_sel; const float* cv_sel; const float* ck_win; const float* cv_win;
    const int* page_table;
    const float* norm_g; const float* w_in;
    const float* ck_w1; const float* ck_b1; const float* ck_w2; const float* ck_b2;
    const float* cv_w1; const float* cv_b1; const float* cv_w2; const float* cv_b2;
    const float* v_norm_g; const float* v_norm_b; const float* w_spatial; const float* b_spatial;
    const float* w_pa; const float* w_pb; const float* w_o; const float* final_g;
    float* out;
    float* rope;
    float* h;
    float* proj;
    float* hid;
    float* kc_p; float* vc_p; float* kc_s; float* vc_s;
    float* o;
    float* vn;
    float* a2;
};

__device__ __forceinline__ float gelu_tanh(float x) {
    const float c = 0.7978845608028654f;
    float u = c * (x + 0.044715f * x * x * x);
    return 0.5f * x * (1.0f + tanhf(u));
}
__device__ __forceinline__ float sigmoidf_(float x) { return 1.0f / (1.0f + expf(-x)); }
__device__ __forceinline__ float siluf_(float x) { return x * sigmoidf_(x); }
__device__ __forceinline__ float wave_sum(float v) {
#pragma unroll
    for (int o = 32; o > 0; o >>= 1) v += __shfl_xor(v, o);
    return v;
}
__device__ __forceinline__ float wave_max(float v) {
#pragma unroll
    for (int o = 32; o > 0; o >>= 1) v = fmaxf(v, __shfl_xor(v, o));
    return v;
}
__device__ __forceinline__ const float* xrow(const Params& p, int r) {
    return r < MP ? p.x_prompt + (size_t)r * 1024 : p.x_sample + (size_t)(r - MP) * 1024;
}
__device__ __forceinline__ int row_pos(int r) { return r < MP ? (r & (SEQ - 1)) : PAST_LEN + ((r - MP) & 3); }

template <class AL, class BL, class EP>
__device__ __forceinline__ void sgemm_tiles(int M, int N, int K, const AL& al, const BL& bl, const EP& ep, int bid, int nblk, float* lds) {
    const int tid = threadIdx.x, tx = tid & 15, ty = tid >> 4;
    const int tm = (M + 63) / 64, tn = (N + 63) / 64;
    float (*As)[68] = (float (*)[68])lds;
    float (*Bs)[68] = (float (*)[68])(lds + 16 * 68);
    for (int tile = bid; tile < tm * tn; tile += nblk) {
        const int m0 = (tile / tn) * 64, n0 = (tile % tn) * 64;
        float acc[4][4];
#pragma unroll
        for (int i = 0; i < 4; ++i)
#pragma unroll
            for (int j = 0; j < 4; ++j) acc[i][j] = 0.f;
        for (int k0 = 0; k0 < K; k0 += 16) {
            {
                const int r = tid >> 2, kq = (tid & 3) * 4;
                float4 v = make_float4(0.f, 0.f, 0.f, 0.f);
                if (m0 + r < M) v = al(m0 + r, k0 + kq, n0);
                As[kq + 0][r] = v.x; As[kq + 1][r] = v.y; As[kq + 2][r] = v.z; As[kq + 3][r] = v.w;
            }
            {
                const int kk = tid >> 4, c = (tid & 15) * 4;
                float4 v = make_float4(0.f, 0.f, 0.f, 0.f);
                if (n0 + c < N) v = bl(k0 + kk, n0 + c, m0);
                *(float4*)&Bs[kk][c] = v;
            }
            __syncthreads();
#pragma unroll
            for (int kk = 0; kk < 16; ++kk) {
                const float4 a = *(const float4*)&As[kk][ty * 4];
                const float4 b = *(const float4*)&Bs[kk][tx * 4];
                acc[0][0] += a.x * b.x; acc[0][1] += a.x * b.y; acc[0][2] += a.x * b.z; acc[0][3] += a.x * b.w;
                acc[1][0] += a.y * b.x; acc[1][1] += a.y * b.y; acc[1][2] += a.y * b.z; acc[1][3] += a.y * b.w;
                acc[2][0] += a.z * b.x; acc[2][1] += a.z * b.y; acc[2][2] += a.z * b.z; acc[2][3] += a.z * b.w;
                acc[3][0] += a.w * b.x; acc[3][1] += a.w * b.y; acc[3][2] += a.w * b.z; acc[3][3] += a.w * b.w;
            }
            __syncthreads();
        }
#pragma unroll
        for (int i = 0; i < 4; ++i) {
            const int row = m0 + ty * 4 + i, col = n0 + tx * 4;
            if (row < M && col < N) ep(row, col, make_float4(acc[i][0], acc[i][1], acc[i][2], acc[i][3]));
        }
    }
}

__device__ void phase_prep(const Params& p, int bid, int nblk) {
    const int tid = threadIdx.x, lane = tid & 63, wid = tid >> 6;
    for (int i = bid * 256 + tid; i < ROPE_NPOS * 8; i += nblk * 256) {
        const int pos = i >> 3, f = i & 7;
        const double inv[8] = {1.0, 0.19392274474868576, 0.03760603093086393, 0.007292664737217109,
                               0.001414213562373095, 0.0002742481756762073, 5.318295896944988e-05, 1.031338537721246e-05};
        double invf = inv[0];
#pragma unroll
        for (int j = 1; j < 8; ++j) invf = (f == j) ? inv[j] : invf;
        const double a = (double)pos * invf * 0.15915494309189535;
        const float rf = (float)((a - rint(a)) * 6.283185307179586);
        p.rope[i * 2 + 0] = cosf(rf);
        p.rope[i * 2 + 1] = sinf(rf);
    }
    for (int r = bid * 4 + wid; r < MT; r += nblk * 4) {
        const float* x = xrow(p, r);
        float4 v[4];
        float ss = 0.f;
#pragma unroll
        for (int i = 0; i < 4; ++i) {
            v[i] = *(const float4*)(x + (i * 64 + lane) * 4);
            ss += v[i].x * v[i].x + v[i].y * v[i].y + v[i].z * v[i].z + v[i].w * v[i].w;
        }
        ss = wave_sum(ss);
        const float rs = rsqrtf(ss * (1.0f / 1024.0f) + 1e-6f);
#pragma unroll
        for (int i = 0; i < 4; ++i) {
            const float4 g = *(const float4*)(p.norm_g + (i * 64 + lane) * 4);
            float4 o;
            o.x = v[i].x * rs * g.x; o.y = v[i].y * rs * g.y; o.z = v[i].z * rs * g.z; o.w = v[i].w * rs * g.w;
            *(float4*)(p.h + (size_t)r * 1024 + (i * 64 + lane) * 4) = o;
        }
    }
}

__device__ void phase_proj(const Params& p, int bid, int nblk, float* lds) {
    const float* h = p.h; const float* w = p.w_in; float* proj = p.proj;
    auto al = [=](int row, int k, int) { return *(const float4*)(h + (size_t)row * 1024 + k); };
    auto bl = [=](int k, int col, int) { return *(const float4*)(w + (size_t)k * IN_WIDTH + col); };
    auto ep = [=](int row, int col, float4 a) { *(float4*)(proj + (size_t)row * IN_WIDTH + col) = a; };
    sgemm_tiles(MT, IN_WIDTH, 1024, al, bl, ep, bid, nblk, lds);
}

__device__ void phase_post(const Params& p, int bid, int nblk) {
    const int tid = threadIdx.x;
    const long total = (long)MT * 1280;
    for (long i = (long)bid * 256 + tid; i < total; i += (long)nblk * 256) {
        const int r = (int)(i / 1280), c = (int)(i % 1280);
        const int d = c & 63;
        float* pr = p.proj + (size_t)r * IN_WIDTH;
        const bool roped = (c < 512) || (c >= C_KS && c < C_VS) || (c >= C_KW && c < C_VW);
        if (roped && d < 8) {
            const int pos = row_pos(r);
            const float cs = p.rope[(pos * 8 + d) * 2], sn = p.rope[(pos * 8 + d) * 2 + 1];
            const float x1 = pr[c], x2 = pr[c + 8];
            pr[c] = x1 * cs - x2 * sn;
            pr[c + 8] = x2 * cs + x1 * sn;
        }
    }
}
__device__ void phase_state_out(const Params& p, int bid, int nblk) {
    const int tid = threadIdx.x;
    const long total = (long)MT * 768;
    for (long i = (long)bid * 256 + tid; i < total; i += (long)nblk * 256) {
        const int r = (int)(i / 768), cc = (int)(i % 768);
        const int sec = cc >> 7, w = cc & 127;
        const float v = p.proj[(size_t)r * IN_WIDTH + 512 + cc];
        if (r < MP) {
            const int b = r >> 12, t = r & 4095;
            if (sec < 4) p.out[O_PKC + (size_t)sec * MP * 128 + (size_t)r * 128 + w] = v;
            else if (t >= SEQ - 512) p.out[(sec == 4 ? O_PKW : O_PVW) + ((size_t)b * 512 + (t - (SEQ - 512))) * 128 + w] = v;
        } else {
            const int rs = r - MP, b = rs >> 2, t = rs & 3;
            if (sec < 4) p.out[O_SKC + (size_t)sec * MS * 128 + (size_t)rs * 128 + w] = v;
            else p.out[(sec == 4 ? O_SKW : O_SVW) + ((size_t)b * 512 + 508 + t) * 128 + w] = v;
        }
    }
    const long tot2 = (long)DEC_BATCH * 508 * 128;
    for (long i = (long)bid * 256 + tid; i < tot2; i += (long)nblk * 256) {
        const int b = (int)(i / (508 * 128)), rem = (int)(i % (508 * 128));
        const int j = rem >> 7, w = rem & 127;
        p.out[O_SKW + ((size_t)b * 512 + j) * 128 + w] = p.ck_win[((size_t)b * 512 + j + 4) * 128 + w];
        p.out[O_SVW + ((size_t)b * 512 + j) * 128 + w] = p.cv_win[((size_t)b * 512 + j + 4) * 128 + w];
    }
}

template <int var>
__device__ __forceinline__ void phase_cmp1_v(const Params& p, int bid, int nblk, float* lds) {
    {
        constexpr bool samp = var >= 2, isv = var & 1;
        const int ncmp = samp ? NCMP_S : NCMP_P;
        const int rows = (samp ? DEC_BATCH : BATCH) * ncmp * 2;
        const float* w1 = isv ? p.cv_w1 : p.ck_w1; const float* b1 = isv ? p.cv_b1 : p.ck_b1;
        float* hid = p.hid + (size_t)(var == 0 ? 0 : var == 1 ? 2040 : var == 2 ? 4080 : 4080 + 32704) * 128;
        const float* proj = p.proj; const float* pool = isv ? p.cv_cmp : p.ck_cmp; const int* pt = p.page_table;
        const int ccol = isv ? C_VC : C_KC;
        auto al = [=](int rc, int k, int) {
            const int g = rc & 1, bc = rc >> 1, b = bc / ncmp, c = bc - b * ncmp;
            const int pos = c * 16 + (k >> 6), d = k & 63;
            if (!samp) return *(const float4*)(proj + (size_t)(b * SEQ + pos) * IN_WIDTH + ccol + g * 64 + d);
            const int phys = pt[b * N_PAGES + (pos >> 7)];
            return *(const float4*)(pool + (((size_t)phys * 128 + (pos & 127)) * 2 + g) * 64 + d);
        };
        auto bl = [=](int k, int col, int) { return *(const float4*)(w1 + (size_t)k * 128 + col); };
        auto ep = [=](int row, int col, float4 a) {
            const float4 bb = *(const float4*)(b1 + col);
            float4 o; o.x = gelu_tanh(a.x + bb.x); o.y = gelu_tanh(a.y + bb.y); o.z = gelu_tanh(a.z + bb.z); o.w = gelu_tanh(a.w + bb.w);
            *(float4*)(hid + (size_t)row * 128 + col) = o;
        };
        sgemm_tiles(rows, 128, 2048, al, bl, ep, bid, nblk, lds);
    }
}
__device__ void phase_cmp1(const Params& p, int bid, int nblk, float* lds) {
    phase_cmp1_v<0>(p, bid, nblk, lds); phase_cmp1_v<1>(p, bid, nblk, lds); phase_cmp1_v<2>(p, bid, nblk, lds); phase_cmp1_v<3>(p, bid, nblk, lds);
}
template <int var>
__device__ __forceinline__ void phase_cmp2_v(const Params& p, int bid, int nblk, float* lds) {
    {
        constexpr bool samp = var >= 2, isv = var & 1;
        const int ncmp = samp ? NCMP_S : NCMP_P;
        const int rows = (samp ? DEC_BATCH : BATCH) * ncmp * 2;
        const float* w2 = isv ? p.cv_w2 : p.ck_w2; const float* b2 = isv ? p.cv_b2 : p.ck_b2;
        const float* hid = p.hid + (size_t)(var == 0 ? 0 : var == 1 ? 2040 : var == 2 ? 4080 : 4080 + 32704) * 128;
        float* outp = var == 0 ? p.kc_p : var == 1 ? p.vc_p : var == 2 ? p.kc_s : p.vc_s;
        auto al = [=](int rc, int k, int) { return *(const float4*)(hid + (size_t)rc * 128 + k); };
        auto bl = [=](int k, int col, int) { return *(const float4*)(w2 + (size_t)k * 64 + col); };
        auto ep = [=](int row, int col, float4 a) {
            const float4 bb = *(const float4*)(b2 + col);
            float4 o; o.x = a.x + bb.x; o.y = a.y + bb.y; o.z = a.z + bb.z; o.w = a.w + bb.w;
            *(float4*)(outp + (size_t)row * 64 + col) = o;
        };
        sgemm_tiles(rows, 64, 128, al, bl, ep, bid, nblk, lds);
    }
}
__device__ void phase_cmp2(const Params& p, int bid, int nblk, float* lds) {
    phase_cmp2_v<0>(p, bid, nblk, lds); phase_cmp2_v<1>(p, bid, nblk, lds); phase_cmp2_v<2>(p, bid, nblk, lds); phase_cmp2_v<3>(p, bid, nblk, lds);
}
__device__ void phase_cmp3(const Params& p, int bid, int nblk) {
    const int tid = threadIdx.x;
#pragma unroll
    for (int var = 0; var < 2; ++var) {
        const int ncmp = var ? NCMP_S : NCMP_P;
        const int rows = (var ? DEC_BATCH : BATCH) * ncmp * 2;
        float* kc = var ? p.kc_s : p.kc_p;
        for (int i = bid * 256 + tid; i < rows * 8; i += nblk * 256) {
            const int rc = i >> 3, d = i & 7;
            const int c = (rc >> 1) % ncmp;
            const int pos = c * 16 + 31;
            const float cs = p.rope[(pos * 8 + d) * 2], sn = p.rope[(pos * 8 + d) * 2 + 1];
            float* row = kc + (size_t)rc * 64;
            const float x1 = row[d], x2 = row[d + 8];
            row[d] = x1 * cs - x2 * sn;
            row[d + 8] = x2 * cs + x1 * sn;
        }
    }
}

__device__ __forceinline__ float dot64(const float* q_lds, const float* krow) {
    float s = 0.f;
#pragma unroll
    for (int i = 0; i < 16; ++i) {
        const float4 kv = *(const float4*)(krow + i * 4);
        const float4 qv = *(const float4*)(q_lds + i * 4);
        s += kv.x * qv.x + kv.y * qv.y + kv.z * qv.z + kv.w * qv.w;
    }
    return s;
}
__device__ __forceinline__ void wave_softmax(float* sc, int n, int lane) {
    float m = -INFINITY;
    for (int i = lane; i < n; i += 64) m = fmaxf(m, sc[i]);
    m = wave_max(m);
    float sum = 0.f;
    for (int i = lane; i < n; i += 64) { const float e = (sc[i] == -INFINITY) ? 0.f : expf(sc[i] - m); sc[i] = e; sum += e; }
    sum = wave_sum(sum);
    const float inv = 1.0f / sum;
    for (int i = lane; i < n; i += 64) sc[i] *= inv;
}

__device__ void phase_attn(const Params& p, int bid, int nblk, float* lds) {
    const int tid = threadIdx.x, lane = tid & 63, w = tid >> 6;
    float* sc = lds + w * 1024;
    float* qs = lds + 4096 + w * 64;
    float* score = lds + 4096 + 256;
    int* selidx = (int*)(lds + 4096 + 256 + 192);
    for (int u = bid; u < MT * 2; u += nblk) {
        const int r = u >> 1, g = u & 1;
        const bool samp = r >= MP;
        const int b = samp ? ((r - MP) >> 2) : (r >> 12);
        const int qpos = row_pos(r);
        const int head = g * 4 + w;
        const int ncmp = samp ? NCMP_S : NCMP_P, nsel = samp ? NSEL_S : NSEL_P;
        const float* prow = p.proj + (size_t)r * IN_WIDTH;
        qs[lane] = prow[C_Q + head * 64 + lane] * 0.125f;
        int nvis = qpos >= 31 ? ((qpos - 31) >> 4) + 1 : 0;
        if (nvis > ncmp) nvis = ncmp;
        const float* kc = (samp ? p.kc_s : p.kc_p) + ((size_t)b * ncmp * 2 + g) * 64;
        const float* vc = (samp ? p.vc_s : p.vc_p) + ((size_t)b * ncmp * 2 + g) * 64;
        for (int c = lane; c < 512; c += 64) sc[c] = (c < nvis) ? dot64(qs, kc + (size_t)c * 128) : -INFINITY;
        float o_cmp = 0.f;
        if (nvis > 0) {
            wave_softmax(sc, 512, lane);
            for (int c = 0; c < nvis; ++c) o_cmp += sc[c] * vc[(size_t)c * 128 + lane];
        } else {
            for (int c = lane; c < 512; c += 64) sc[c] = 0.f;
        }
        __syncthreads();
        if (tid < nsel) {
            const int s = tid;
            float imp = 0.f;
#pragma unroll
            for (int ww = 0; ww < 4; ++ww) {
                const float* pc = lds + ww * 1024;
                const int c0 = 4 * s;
                float a = 0.f;
                if (c0 - 1 >= 0 && c0 - 1 < nvis) a += 0.5f * pc[c0 - 1];
                if (c0 < nvis) a += pc[c0];
                if (c0 + 1 < nvis) a += pc[c0 + 1];
                if (c0 + 2 < nvis) a += pc[c0 + 2];
                if (c0 + 3 < nvis) a += 0.5f * pc[c0 + 3];
                imp += a;
            }
            const int cur = qpos >> 6;
            const bool valid = s <= cur;
            const bool forced = (valid && s > cur - 2) || s < 1;
            score[s] = forced ? 1e30f : (valid ? imp : -1e30f);
        }
        __syncthreads();
        if (w == 0) {
            float v0 = lane < nsel ? score[lane] : -3e38f;
            float v1 = lane + 64 < nsel ? score[lane + 64] : -3e38f;
            float v2 = lane + 128 < nsel ? score[lane + 128] : -3e38f;
            for (int n = 0; n < 16; ++n) {
                float bv = v0; int bi = lane;
                if (v1 > bv) { bv = v1; bi = lane + 64; }
                if (v2 > bv) { bv = v2; bi = lane + 128; }
#pragma unroll
                for (int o = 32; o > 0; o >>= 1) {
                    const float ov = __shfl_xor(bv, o); const int oi = __shfl_xor(bi, o);
                    if (ov > bv || (ov == bv && oi < bi)) { bv = ov; bi = oi; }
                }
                if (lane == 0) selidx[n] = bi;
                if (bi == lane) v0 = -3e38f;
                if (bi == lane + 64) v1 = -3e38f;
                if (bi == lane + 128) v2 = -3e38f;
            }
        }
        __syncthreads();
        for (int n = 0; n < 16; ++n) {
            const int blk = selidx[n];
            const int kp = blk * 64 + lane;
            const float* krow = nullptr;
            if (!samp) krow = p.proj + (size_t)(b * SEQ + kp) * IN_WIDTH + C_KS + g * 64;
            else if (blk < 128) krow = p.ck_sel + (((size_t)p.page_table[b * N_PAGES + (blk >> 1)] * 128 + (blk & 1) * 64 + lane) * 2 + g) * 64;
            else if (lane < 4) krow = p.proj + (size_t)(MP + b * 4 + lane) * IN_WIDTH + C_KS + g * 64;
            sc[n * 64 + lane] = (kp <= qpos && krow) ? dot64(qs, krow) : -INFINITY;
        }
        wave_softmax(sc, 1024, lane);
        float o_sel = 0.f;
        for (int n = 0; n < 16; ++n) {
            const int blk = selidx[n];
            const float* vbase; size_t vstride;
            int kmax = 64;
            if (!samp) { vbase = p.proj + (size_t)(b * SEQ + blk * 64) * IN_WIDTH + C_VS + g * 64; vstride = IN_WIDTH; }
            else if (blk < 128) { vbase = p.cv_sel + (((size_t)p.page_table[b * N_PAGES + (blk >> 1)] * 128 + (blk & 1) * 64) * 2 + g) * 64; vstride = 128; }
            else { vbase = p.proj + (size_t)(MP + b * 4) * IN_WIDTH + C_VS + g * 64; vstride = IN_WIDTH; kmax = 4; }
            if (blk * 64 > qpos) kmax = 0;
            for (int k = 0; k < kmax; ++k) o_sel += sc[n * 64 + k] * vbase[(size_t)k * vstride + lane];
        }
        for (int i = lane; i < 512; i += 64) {
            const int kp = qpos - 511 + i;
            const float* krow = nullptr;
            if (kp >= 0) {
                if (!samp) krow = p.proj + (size_t)(b * SEQ + kp) * IN_WIDTH + C_KW + g * 64;
                else if (kp < PAST_LEN) krow = p.ck_win + (((size_t)b * 512 + (kp - (PAST_LEN - 512))) * 2 + g) * 64;
                else krow = p.proj + (size_t)(MP + b * 4 + (kp - PAST_LEN)) * IN_WIDTH + C_KW + g * 64;
            }
            sc[i] = krow ? dot64(qs, krow) : -INFINITY;
        }
        wave_softmax(sc, 512, lane);
        float o_win = 0.f;
        for (int i = 0; i < 512; ++i) {
            const int kp = qpos - 511 + i;
            if (kp < 0) continue;
            const float* vrow;
            if (!samp) vrow = p.proj + (size_t)(b * SEQ + kp) * IN_WIDTH + C_VW + g * 64;
            else if (kp < PAST_LEN) vrow = p.cv_win + (((size_t)b * 512 + (kp - (PAST_LEN - 512))) * 2 + g) * 64;
            else vrow = p.proj + (size_t)(MP + b * 4 + (kp - PAST_LEN)) * IN_WIDTH + C_VW + g * 64;
            o_win += sc[i] * vrow[lane];
        }
        const float g0 = sigmoidf_(prow[C_GL + head * 3 + 0]), g1 = sigmoidf_(prow[C_GL + head * 3 + 1]), g2 = sigmoidf_(prow[C_GL + head * 3 + 2]);
        p.o[(size_t)r * 512 + head * 64 + lane] = g0 * o_cmp + g1 * o_sel + g2 * o_win;
        __syncthreads();
    }
}

__device__ void phase_vn(const Params& p, int bid, int nblk) {
    const int tid = threadIdx.x, lane = tid & 63, wid = tid >> 6;
    for (int r = bid * 4 + wid; r < MT; r += nblk * 4) {
        const float* v = p.proj + (size_t)r * IN_WIDTH + C_V;
        float ge[8]; float s = 0.f;
#pragma unroll
        for (int i = 0; i < 8; ++i) { ge[i] = gelu_tanh(v[i * 64 + lane]); s += ge[i]; }
        const float mu = wave_sum(s) * (1.0f / 512.0f);
        float q = 0.f;
#pragma unroll
        for (int i = 0; i < 8; ++i) { const float d = ge[i] - mu; q += d * d; }
        const float rstd = rsqrtf(wave_sum(q) * (1.0f / 512.0f) + 1e-6f);
#pragma unroll
        for (int i = 0; i < 8; ++i) {
            const int c = i * 64 + lane;
            const float y = (ge[i] - mu) * rstd * p.v_norm_g[c] + p.v_norm_b[c];
            p.vn[(size_t)r * 512 + c] = y;
            if (r >= MP) p.out[O_SVCH + (size_t)(r - MP) * 512 + c] = y;
        }
    }
}

__device__ void phase_spatial(const Params& p, int bid, int nblk, float* lds) {
    const float* vn = p.vn; const float* proj = p.proj; float* a2 = p.a2;
#pragma unroll 1
    for (int g = 0; g < 4; ++g) {
        const float* W = p.w_spatial + (size_t)g * 128 * 128; const float* bs = p.b_spatial + g * 128;
        auto al = [=](int row, int k, int) {
            const int t = row & 127;
            float4 v = *(const float4*)(W + (size_t)t * 128 + k);
            if (k + 0 > t) v.x = 0.f; if (k + 1 > t) v.y = 0.f; if (k + 2 > t) v.z = 0.f; if (k + 3 > t) v.w = 0.f;
            return v;
        };
        auto bl = [=](int k, int col, int m0) { return *(const float4*)(vn + (size_t)((m0 & ~127) + k) * 512 + g * 128 + col); };
        auto ep = [=](int row, int col, float4 a) {
            const int t = row & 127; const float bb = bs[t];
            const float4 u = *(const float4*)(proj + (size_t)row * IN_WIDTH + C_U + g * 128 + col);
            const float4 z = *(const float4*)(proj + (size_t)row * IN_WIDTH + C_ZB + g * 128 + col);
            float4 o;
            o.x = gelu_tanh(u.x) * (a.x + bb) * siluf_(z.x); o.y = gelu_tanh(u.y) * (a.y + bb) * siluf_(z.y);
            o.z = gelu_tanh(u.z) * (a.z + bb) * siluf_(z.z); o.w = gelu_tanh(u.w) * (a.w + bb) * siluf_(z.w);
            *(float4*)(a2 + (size_t)row * 512 + g * 128 + col) = o;
        };
        sgemm_tiles(MP, 128, 128, al, bl, ep, bid, nblk, lds);
    }
    for (int i = bid * 256 + threadIdx.x; i < MS * 512; i += nblk * 256) {
        const int rs = i >> 9, c = i & 511, g = c >> 7, t = rs & 3, r = MP + rs;
        float acc = p.b_spatial[g * 128 + t];
        for (int s = 0; s <= t; ++s) acc += p.w_spatial[((size_t)g * 128 + t) * 128 + s] * vn[(size_t)(r - t + s) * 512 + c];
        const float u = proj[(size_t)r * IN_WIDTH + C_U + c], z = proj[(size_t)r * IN_WIDTH + C_ZB + c];
        a2[(size_t)r * 512 + c] = gelu_tanh(u) * acc * siluf_(z);
    }
}

__device__ void phase_merge(const Params& p, int bid, int nblk, float* lds, int pass) {
    const float* proj = p.proj; float* mg = p.h;
    if (pass == 0) {
        const float* o = p.o; const float* w = p.w_pa;
        auto al = [=](int row, int k, int) {
            const float4 a = *(const float4*)(o + (size_t)row * 512 + k);
            const float4 z = *(const float4*)(proj + (size_t)row * IN_WIDTH + C_ZA + k);
            return make_float4(a.x * siluf_(z.x), a.y * siluf_(z.y), a.z * siluf_(z.z), a.w * siluf_(z.w));
        };
        auto bl = [=](int k, int col, int) { return *(const float4*)(w + (size_t)k * 1024 + col); };
        auto ep = [=](int row, int col, float4 a) {
            const float4 r = *(const float4*)(proj + (size_t)row * IN_WIDTH + C_RA + col);
            *(float4*)(mg + (size_t)row * 1024 + col) = make_float4(sigmoidf_(r.x) * a.x, sigmoidf_(r.y) * a.y, sigmoidf_(r.z) * a.z, sigmoidf_(r.w) * a.w);
        };
        sgemm_tiles(MT, 1024, 512, al, bl, ep, bid, nblk, lds);
    } else {
        const float* a2 = p.a2; const float* w = p.w_pb;
        auto al = [=](int row, int k, int) { return *(const float4*)(a2 + (size_t)row * 512 + k); };
        auto bl = [=](int k, int col, int) { return *(const float4*)(w + (size_t)k * 1024 + col); };
        auto ep = [=](int row, int col, float4 a) {
            const float4 r = *(const float4*)(proj + (size_t)row * IN_WIDTH + C_RB + col);
            float4 m = *(float4*)(mg + (size_t)row * 1024 + col);
            m.x += sigmoidf_(r.x) * a.x; m.y += sigmoidf_(r.y) * a.y; m.z += sigmoidf_(r.z) * a.z; m.w += sigmoidf_(r.w) * a.w;
            *(float4*)(mg + (size_t)row * 1024 + col) = m;
        };
        sgemm_tiles(MT, 1024, 512, al, bl, ep, bid, nblk, lds);
    }
}

__device__ void phase_wo(const Params& p, int bid, int nblk, float* lds) {
    const float* mg = p.h; const float* w = p.w_o; float* out = p.out;
    const float* xp = p.x_prompt; const float* xs = p.x_sample;
    auto al = [=](int row, int k, int) { return *(const float4*)(mg + (size_t)row * 1024 + k); };
    auto bl = [=](int k, int col, int) { return *(const float4*)(w + (size_t)k * 1024 + col); };
    auto ep = [=](int row, int col, float4 a) {
        const float* x = row < MP ? xp + (size_t)row * 1024 : xs + (size_t)(row - MP) * 1024;
        const float4 xv = *(const float4*)(x + col);
        *(float4*)(out + (size_t)row * 1024 + col) = make_float4(xv.x + a.x, xv.y + a.y, xv.z + a.z, xv.w + a.w);
    };
    sgemm_tiles(MT, 1024, 1024, al, bl, ep, bid, nblk, lds);
}
__device__ void phase_final(const Params& p, int bid, int nblk) {
    const int tid = threadIdx.x, lane = tid & 63, wid = tid >> 6;
    for (int r = bid * 4 + wid; r < MT; r += nblk * 4) {
        float* x = p.out + (size_t)r * 1024;
        float4 v[4]; float ss = 0.f;
#pragma unroll
        for (int i = 0; i < 4; ++i) {
            v[i] = *(const float4*)(x + (i * 64 + lane) * 4);
            ss += v[i].x * v[i].x + v[i].y * v[i].y + v[i].z * v[i].z + v[i].w * v[i].w;
        }
        ss = wave_sum(ss);
        const float rs = rsqrtf(ss * (1.0f / 1024.0f) + 1e-6f);
#pragma unroll
        for (int i = 0; i < 4; ++i) {
            const float4 g = *(const float4*)(p.final_g + (i * 64 + lane) * 4);
            float4 o;
            o.x = v[i].x * rs * g.x; o.y = v[i].y * rs * g.y; o.z = v[i].z * rs * g.z; o.w = v[i].w * rs * g.w;
            *(float4*)(x + (i * 64 + lane) * 4) = o;
        }
    }
}

constexpr int N_PHASES = 13;
__device__ __forceinline__ void run_phase(int ph, const Params& p, int bid, int nblk, float* lds) {
    switch (ph) {
        case 0: phase_prep(p, bid, nblk); break;
        case 1: phase_proj(p, bid, nblk, lds); break;
        case 2: phase_post(p, bid, nblk); break;
        case 3: phase_state_out(p, bid, nblk); phase_cmp1(p, bid, nblk, lds); break;
        case 4: phase_cmp2(p, bid, nblk, lds); break;
        case 5: phase_cmp3(p, bid, nblk); phase_vn(p, bid, nblk); break;
        case 6: phase_attn(p, bid, nblk, lds); break;
        case 7: phase_spatial(p, bid, nblk, lds); break;
        case 8: phase_merge(p, bid, nblk, lds, 0); break;
        case 9: phase_merge(p, bid, nblk, lds, 1); break;
        case 10: phase_wo(p, bid, nblk, lds); break;
        case 11: phase_final(p, bid, nblk); break;
        default: break;
    }
}

__global__ void __launch_bounds__(256) k_phase(Params p, int ph) {
    __shared__ __attribute__((aligned(16))) float lds[4096 + 256 + 192 + 16];
    run_phase(ph, p, blockIdx.x, gridDim.x, lds);
}

__global__ void __launch_bounds__(256) k_mega(Params p) {
    __shared__ __attribute__((aligned(16))) float lds[4096 + 256 + 192 + 16];
    cg::grid_group grid = cg::this_grid();
    const int bid = blockIdx.x, nblk = gridDim.x;
    phase_prep(p, bid, nblk); grid.sync();
    phase_proj(p, bid, nblk, lds); grid.sync();
    phase_post(p, bid, nblk); grid.sync();
    phase_state_out(p, bid, nblk); phase_cmp1(p, bid, nblk, lds); grid.sync();
    phase_cmp2(p, bid, nblk, lds); grid.sync();
    phase_cmp3(p, bid, nblk); phase_vn(p, bid, nblk); grid.sync();
    phase_attn(p, bid, nblk, lds); grid.sync();
    phase_spatial(p, bid, nblk, lds); grid.sync();
    phase_merge(p, bid, nblk, lds, 0); grid.sync();
    phase_merge(p, bid, nblk, lds, 1); grid.sync();
    phase_wo(p, bid, nblk, lds); grid.sync();
    phase_final(p, bid, nblk);
}

extern "C" void kernel_launch(void* const* d_in, const int* in_sizes, int n_in, void* d_out, int out_size, void* d_ws, size_t ws_size, hipStream_t stream) {
    Params p{};
    p.x_prompt = (const float*)d_in[0]; p.x_sample = (const float*)d_in[1];
    p.ck_cmp = (const float*)d_in[2]; p.cv_cmp = (const float*)d_in[3]; p.ck_sel = (const float*)d_in[4]; p.cv_sel = (const float*)d_in[5];
    p.ck_win = (const float*)d_in[6]; p.cv_win = (const float*)d_in[7]; p.page_table = (const int*)d_in[8];
    p.norm_g = (const float*)d_in[9]; p.w_in = (const float*)d_in[10];
    p.ck_w1 = (const float*)d_in[11]; p.ck_b1 = (const float*)d_in[12]; p.ck_w2 = (const float*)d_in[13]; p.ck_b2 = (const float*)d_in[14];
    p.cv_w1 = (const float*)d_in[15]; p.cv_b1 = (const float*)d_in[16]; p.cv_w2 = (const float*)d_in[17]; p.cv_b2 = (const float*)d_in[18];
    p.v_norm_g = (const float*)d_in[19]; p.v_norm_b = (const float*)d_in[20]; p.w_spatial = (const float*)d_in[21]; p.b_spatial = (const float*)d_in[22];
    p.w_pa = (const float*)d_in[23]; p.w_pb = (const float*)d_in[24]; p.w_o = (const float*)d_in[25]; p.final_g = (const float*)d_in[26];
    p.out = (float*)d_out;
    float* ws = (float*)d_ws; size_t off = 0;
    auto take = [&](size_t n) { float* q = ws + off; off += (n + 63) & ~(size_t)63; return q; };
    p.rope = take((size_t)ROPE_NPOS * 16);
    p.h = take((size_t)MT * 1024);
    p.proj = take((size_t)MT * IN_WIDTH);
    p.hid = take((size_t)(4080 + 2 * 32704) * 128);
    p.kc_p = take((size_t)2040 * 64); p.vc_p = take((size_t)2040 * 64);
    p.kc_s = take((size_t)32704 * 64); p.vc_s = take((size_t)32704 * 64);
    p.o = take((size_t)MT * 512);
    p.vn = take((size_t)MT * 512);
    p.a2 = take((size_t)MT * 512);
    if (off * sizeof(float) > ws_size) { fprintf(stderr, "workspace too small: need %zu have %zu\n", off * sizeof(float), ws_size); return; }
#if ONE_LAUNCH
    static int grid_blocks = 0;
    if (!grid_blocks) {
        int dev = 0, cus = 0, per_cu = 0;
        hipGetDevice(&dev);
        hipDeviceGetAttribute(&cus, hipDeviceAttributeMultiprocessorCount, dev);
        hipOccupancyMaxActiveBlocksPerMultiprocessor(&per_cu, k_mega, 256, 0);
        if (per_cu > 4) per_cu = 4;
        grid_blocks = cus * per_cu;
    }
    void* args[] = {&p};
    hipError_t e = hipLaunchCooperativeKernel((void*)k_mega, dim3(grid_blocks), dim3(256), args, 0, stream);
    if (e != hipSuccess) fprintf(stderr, "cooperative launch failed: %s (grid %d)\n", hipGetErrorString(e), grid_blocks);
#else
    for (int ph = 0; ph < 12; ++ph) k_phase<<<2048, 256, 0, stream>>>(p, ph);
#endif
}
```

```cpp
#include <hip/hip_runtime.h>
#include <hip/hip_cooperative_groups.h>
#include <cstdint>
#include <cstdio>
namespace cg = cooperative_groups;
__device__ __forceinline__ int tid_opaque() { int t = threadIdx.x; asm volatile("" : "+v"(t)); return t; }

constexpr int BATCH = 4, SEQ = 4096, DEC_BATCH = 32, PAST_LEN = 8192;
constexpr int IN_WIDTH = 5400;
constexpr int MP = BATCH * SEQ;
constexpr int MS = DEC_BATCH * 4;
constexpr int MT = MP + MS;
constexpr int MPAD = 16640;
constexpr int LDP = 5632;
constexpr int N_PAGES = 64;
constexpr int NCMP_P = 255, NCMP_S = 511;
constexpr int NSEL_P = 64, NSEL_S = 129;
constexpr int C_Q = 0, C_KC = 512, C_VC = 640, C_KS = 768, C_VS = 896, C_KW = 1024, C_VW = 1152, C_GL = 1280,
              C_ZA = 1304, C_U = 1816, C_V = 2328, C_ZB = 2840, C_RA = 3352, C_RB = 4376;
constexpr size_t O_YP = 0;
constexpr size_t O_YS = O_YP + (size_t)MP * 1024;
constexpr size_t O_PKC = O_YS + (size_t)MS * 1024;
constexpr size_t O_PVC = O_PKC + (size_t)MP * 128;
constexpr size_t O_PKS = O_PVC + (size_t)MP * 128;
constexpr size_t O_PVS = O_PKS + (size_t)MP * 128;
constexpr size_t O_PKW = O_PVS + (size_t)MP * 128;
constexpr size_t O_PVW = O_PKW + (size_t)BATCH * 512 * 128;
constexpr size_t O_SKC = O_PVW + (size_t)BATCH * 512 * 128;
constexpr size_t O_SVC = O_SKC + (size_t)MS * 128;
constexpr size_t O_SKS = O_SVC + (size_t)MS * 128;
constexpr size_t O_SVS = O_SKS + (size_t)MS * 128;
constexpr size_t O_SKW = O_SVS + (size_t)MS * 128;
constexpr size_t O_SVW = O_SKW + (size_t)DEC_BATCH * 512 * 128;
constexpr size_t O_SVCH = O_SVW + (size_t)DEC_BATCH * 512 * 128;
constexpr size_t O_TOTAL = O_SVCH + (size_t)MS * 512;
static_assert(O_TOTAL == 30146560, "output size");
constexpr int ROPE_NPOS = 8200;
constexpr int CMPA_ROWS = 69632;
constexpr int LDS_BYTES = 131072 + 256;

namespace pg8 {
#define PG8_LAS __attribute__((address_space(3)))
typedef unsigned short bf16_t;
typedef short bf16x8 __attribute__((ext_vector_type(8)));
typedef float f32x4 __attribute__((ext_vector_type(4)));
typedef unsigned u32x4 __attribute__((ext_vector_type(4)));
constexpr int BM = 256, BK = 64, HALF = 128, HTB = HALF * BK * 2  , STAGE_BYTES = 8 * HTB, NXCD = 8, WGM = 8;

__host__ __device__ __forceinline__ int lds_byte(int r, int c) { const int st = (r >> 4) * 2 + (c >> 5), rr = r & 15, cc = c & 31, ob = rr * 64 + cc * 2; return st * 1024 + (ob ^ (((ob >> 9) & 1) << 5)); }
__host__ __device__ __forceinline__ void stage_rc(int b, int& R, int& C) { const int st = b / 1024, sb = b % 1024, swz = sb ^ (((sb >> 9) & 1) << 5); R = (st >> 1) * 16 + swz / 64; C = (st & 1) * 32 + (swz % 64) / 2; }
__host__ __device__ __forceinline__ int perm32(int rho) { const int n = rho >> 4, i = rho & 15; return 8 * (i >> 2) + 4 * n + (i & 3); }

struct Unit { int pm, pn; };
struct Gemm { const bf16_t* A; const bf16_t* Bt; int M, N, K; };

struct StaticOrder {
    int nM, nN, nwg, G, c;
    __host__ __device__ __forceinline__ void init(int M, int N, int G_, int c_) { nM = M / BM; nN = N / BM; nwg = nM * nN; G = G_; c = c_; }
    __host__ __device__ bool next(int i, Unit& u) const {
        const long L = (long)i * G + c; if (L >= nwg) return false;
        int wgid = (int)L; { const int q = nwg / NXCD, r = nwg % NXCD, xcd = wgid % NXCD, off = wgid / NXCD; wgid = (xcd < r ? xcd * (q + 1) : r * (q + 1) + (xcd - r) * q) + off; }
        const int nig = WGM * nN, gid = wgid / nig, fm = gid * WGM, gsz = (nM - fm) < WGM ? (nM - fm) : WGM;
        u.pm = fm + ((wgid % nig) % gsz); u.pn = (wgid % nig) / gsz; return true;
    }
    __device__ __forceinline__ void a_ready(const Unit&) const {}
    __device__ __forceinline__ void done(const Unit&) const {}
};
__device__ __forceinline__ unsigned cvt_pk_bf16(float lo, float hi) { unsigned r; asm volatile("v_cvt_pk_bf16_f32 %0, %1, %2" : "=v"(r) : "v"(lo), "v"(hi)); return r; }
template <class Epi, class Sched, bool STAMP = false>
__device__ __forceinline__ void gemm_phase(PG8_LAS unsigned char* lds, const Gemm g, const Sched& S, const Epi& E, unsigned long long* stamps) {
    const int tid = tid_opaque(), wid = __builtin_amdgcn_readfirstlane(tid >> 6), lane = tid & 63, wr = wid >> 2, wc = wid & 3, fr = lane & 15, fq = lane >> 4;
    const int K = g.K, nt = K / BK;
    int ts_lo = 0, ts_hi = 0, nts = 0; const unsigned long long rt_entry = STAMP ? (unsigned long long)wall_clock64() : 0ull;
#define PG8_STAMP() do { if (STAMP && wid == 0 && nts < 64) { const unsigned long long _c = (unsigned long long)clock64(); \
        ts_lo = (lane == nts) ? (int)(unsigned)_c : ts_lo; ts_hi = (lane == nts) ? (int)(unsigned)(_c >> 32) : ts_hi; ++nts; } } while (0)
    PG8_STAMP();
    unsigned voffA[2], voffB[2];
#pragma unroll
    for (int i = 0; i < 2; ++i) { int R, C; stage_rc(tid * 16 + i * 8192, R, C); const int Rb = Epi::PERM ? ((R & ~31) + perm32(R & 31)) : R;
        voffA[i] = (unsigned)(R * K + C) * 2u; voffB[i] = (unsigned)(Rb * K + C) * 2u; }
    const size_t kstep = (size_t)(BK * 2);
    const size_t hstep = (size_t)HALF * K * 2;
    const size_t tstep = 2 * hstep;
    const unsigned ldsw = (unsigned)wid * 1024u;
    const int aoff = lds_byte(wr * 64 + fr, fq * 8), boff = lds_byte(wc * 32 + fr, fq * 8);
#define PG8_SA(b, h) (((b) * 2 + (h)) * HTB)
#define PG8_SB(b, h) ((4 + (b) * 2 + (h)) * HTB)
#define PG8_STAGE(bufoff, gbase, voff) do { _Pragma("unroll") for (int _i = 0; _i < 2; ++_i) \
        __builtin_amdgcn_global_load_lds((const unsigned*)((const char*)(gbase) + (voff)[_i]), (PG8_LAS unsigned*)(lds + (bufoff) + ldsw + _i * 8192), 16, 0, 0); } while (0)
#define PG8_LDA(dst, b, h) do { _Pragma("unroll") for (int m = 0; m < 4; ++m) _Pragma("unroll") for (int k = 0; k < 2; ++k) dst[m][k] = *(const PG8_LAS bf16x8*)(lds + PG8_SA(b, h) + aoff + m * 2048 + k * 1024); } while (0)
#define PG8_LDB(dst, b, h) do { _Pragma("unroll") for (int n = 0; n < 2; ++n) _Pragma("unroll") for (int k = 0; k < 2; ++k) dst[n][k] = *(const PG8_LAS bf16x8*)(lds + PG8_SB(b, h) + boff + n * 2048 + k * 1024); } while (0)
#define PG8_MMA(ai, bj, At, Bt) do { __builtin_amdgcn_s_setprio(1); _Pragma("unroll") for (int m = 0; m < 4; ++m) _Pragma("unroll") for (int n = 0; n < 2; ++n) _Pragma("unroll") for (int k = 0; k < 2; ++k) \
        acc[ai][bj][m][n] = __builtin_amdgcn_mfma_f32_16x16x32_bf16(Bt[n][k], At[m][k], acc[ai][bj][m][n], 0, 0, 0); __builtin_amdgcn_s_setprio(0); } while (0)
#define PG8_WAIT_V(n) asm volatile("s_waitcnt vmcnt(" #n ")" ::: "memory")
#define PG8_WAIT_L(n) asm volatile("s_waitcnt lgkmcnt(" #n ")" ::: "memory")
#define PG8_BAR __builtin_amdgcn_s_barrier()
#define PG8_SCHED __builtin_amdgcn_sched_barrier(0)
    Unit cur, nxt; int ui = 0;
    if (!S.next(0, cur)) return;
    f32x4 acc[2][2][4][2];
#pragma unroll
    for (int a = 0; a < 2; ++a)
#pragma unroll
        for (int b = 0; b < 2; ++b)
#pragma unroll
            for (int m = 0; m < 4; ++m)
#pragma unroll
                for (int n = 0; n < 2; ++n) acc[a][b][m][n] = (f32x4){0.f, 0.f, 0.f, 0.f};
    bf16x8 At[4][2], B0[2][2], B1[2][2];
    const char* cA = (const char*)g.A + (size_t)cur.pm * tstep; const char* cB = (const char*)g.Bt + (size_t)cur.pn * tstep;
    S.a_ready(cur);
    PG8_STAGE(PG8_SB(0, 0), cB, voffB); PG8_STAGE(PG8_SA(0, 0), cA, voffA); PG8_STAGE(PG8_SB(0, 1), cB + hstep, voffB); PG8_STAGE(PG8_SA(0, 1), cA + hstep, voffA);
    if (wr == 1) PG8_BAR;
    PG8_WAIT_V(4); PG8_BAR;
    PG8_STAGE(PG8_SB(1, 0), cB + kstep, voffB); PG8_STAGE(PG8_SA(1, 0), cA + kstep, voffA); PG8_STAGE(PG8_SB(1, 1), cB + hstep + kstep, voffB);
    PG8_WAIT_V(6); PG8_BAR;
    PG8_STAMP();
    for (;;) {
        const bool has_next = S.next(ui + 1, nxt);
        const char* nA = has_next ? (const char*)g.A + (size_t)nxt.pm * tstep : cA; const char* nB = has_next ? (const char*)g.Bt + (size_t)nxt.pn * tstep : cB;
        for (int t = 0; t < nt; t += 2) {
            const bool last = (t == nt - 2);
            const char* a1 = cA + (size_t)(t + 1) * kstep;
            const char* a2 = last ? nA : cA + (size_t)(t + 2) * kstep; const char* b2 = last ? nB : cB + (size_t)(t + 2) * kstep;
            const char* a3 = a2 + kstep; const char* b3 = b2 + kstep;
            if (last && has_next) S.a_ready(nxt);
            PG8_LDB(B0, 0, 0); PG8_SCHED; PG8_LDA(At, 0, 0); PG8_STAGE(PG8_SA(1, 1), a1 + hstep, voffA);
            PG8_WAIT_L(8); PG8_BAR; PG8_WAIT_L(0); PG8_MMA(0, 0, At, B0); PG8_BAR; PG8_SCHED;
            PG8_LDB(B1, 0, 1); PG8_STAGE(PG8_SB(0, 0), b2, voffB);
            PG8_BAR; PG8_WAIT_L(0); PG8_MMA(0, 1, At, B1); PG8_BAR;
            PG8_LDA(At, 0, 1); PG8_STAGE(PG8_SA(0, 0), a2, voffA);
            PG8_BAR; PG8_WAIT_L(0); PG8_MMA(1, 0, At, B0); PG8_BAR; PG8_SCHED;
            PG8_STAGE(PG8_SB(0, 1), b2 + hstep, voffB);
            PG8_WAIT_V(6); PG8_BAR; PG8_MMA(1, 1, At, B1); PG8_BAR;
            PG8_LDB(B0, 1, 0); PG8_SCHED; PG8_LDA(At, 1, 0); PG8_STAGE(PG8_SA(0, 1), a2 + hstep, voffA);
            PG8_WAIT_L(8); PG8_BAR; PG8_WAIT_L(0); PG8_MMA(0, 0, At, B0); PG8_BAR; PG8_SCHED;
            PG8_LDB(B1, 1, 1); PG8_STAGE(PG8_SB(1, 0), b3, voffB);
            PG8_BAR; PG8_WAIT_L(0); PG8_MMA(0, 1, At, B1); PG8_BAR;
            PG8_LDA(At, 1, 1); PG8_STAGE(PG8_SA(1, 0), a3, voffA);
            PG8_BAR; PG8_WAIT_L(0); PG8_MMA(1, 0, At, B0); PG8_BAR; PG8_SCHED;
            PG8_STAGE(PG8_SB(1, 1), b3 + hstep, voffB);
            PG8_WAIT_V(6); PG8_BAR; PG8_MMA(1, 1, At, B1); PG8_BAR;
        }
        PG8_STAMP();
        if constexpr (!Epi::AFTER_DRAIN) { E(acc, cur, wr, wc, fr, fq); S.done(cur); }
        PG8_STAMP();
        if (!has_next) break;
#pragma unroll
        for (int a = 0; a < 2; ++a)
#pragma unroll
            for (int b = 0; b < 2; ++b)
#pragma unroll
                for (int m = 0; m < 4; ++m)
#pragma unroll
                    for (int n = 0; n < 2; ++n) acc[a][b][m][n] = (f32x4){0.f, 0.f, 0.f, 0.f};
        cur = nxt; cA = nA; cB = nB; ++ui;
    }
    PG8_WAIT_V(0);
    if (wr == 0) PG8_BAR;
    PG8_BAR;
    if constexpr (Epi::AFTER_DRAIN) { E.fused(acc, cur, wr, wc, fr, fq, lds, wid, lane); S.done(cur); }
    PG8_STAMP();
    if (STAMP && wid == 0) { stamps[lane] = lane < nts ? (((unsigned long long)(unsigned)ts_hi << 32) | (unsigned)ts_lo) : 0ull;
        if (lane == 62) stamps[62] = rt_entry; if (lane == 63) stamps[63] = (unsigned long long)wall_clock64(); }
#undef PG8_STAMP
#undef PG8_SA
#undef PG8_SB
#undef PG8_STAGE
#undef PG8_LDA
#undef PG8_LDB
#undef PG8_MMA
#undef PG8_WAIT_V
#undef PG8_WAIT_L
#undef PG8_BAR
#undef PG8_SCHED
}
}
#define USE_CG_SYNC 1

#define XB_TMO      128
#define XB_XCNT(j)  (256  + 64 * (j))
#define XB_XSUB(j)  (1280 + 64 * (j))
#define XB_XGEN(j)  (2304 + 64 * (j))
#define XB_TOP      3328
#define XB_TOPGEN   3392
#define XCD_BAR_WORDS 3456
#define XB_SPIN_CAP (1u << 18)
#define LAS __attribute__((address_space(3)))
__device__ __forceinline__ unsigned xb_ld(unsigned* p)              { return __hip_atomic_load(p, __ATOMIC_RELAXED, __HIP_MEMORY_SCOPE_AGENT); }
__device__ __forceinline__ unsigned xb_add(unsigned* p, unsigned v) { return __hip_atomic_fetch_add(p, v, __ATOMIC_RELAXED, __HIP_MEMORY_SCOPE_AGENT); }
__device__ __forceinline__ unsigned xb_xcc_id() { return (unsigned)__builtin_amdgcn_s_getreg((3 << 11) | 20) & 0xFu; }
#define XB_SPIN(cond, bar) do { unsigned _sp = 0; while (cond) { __builtin_amdgcn_s_sleep(1); \
    if ((++_sp & 255u) == 0u) { if (xb_ld(&(bar)[XB_TMO])) break; if (_sp > XB_SPIN_CAP) { atomicAdd(&(bar)[XB_TMO], 1u); break; } } } } while (0)
struct XcdBarrier { unsigned* bar; unsigned x; volatile LAS unsigned* st; };
__device__ __forceinline__ XcdBarrier xcd_barrier_post(unsigned* bar, volatile LAS unsigned* st) {
    XcdBarrier b; b.bar = bar; b.x = xb_xcc_id(); b.st = st;
    if (threadIdx.x == 0) (void)xb_add(&bar[XB_XCNT(b.x)], 1u);
    return b;
}
__device__ __forceinline__ void xcd_barrier_complete(unsigned* bar, unsigned x, unsigned& nloc, unsigned& nx) {
    const unsigned G = gridDim.x * gridDim.y * gridDim.z;
    unsigned sum, cnt, mine, sp = 0u;
    for (;;) {
        sum = 0u; cnt = 0u; mine = 0u;
#pragma unroll
        for (unsigned j = 0; j < 16; ++j) { const unsigned c = xb_ld(&bar[XB_XCNT(j)]); sum += c; cnt += (c > 0u) ? 1u : 0u; mine = (j == x) ? c : mine; }
        if (sum == G) break;
        __builtin_amdgcn_s_sleep(1);
        if ((++sp & 255u) == 0u) { if (xb_ld(&bar[XB_TMO])) break; if (sp > XB_SPIN_CAP) { atomicAdd(&bar[XB_TMO], 1u); break; } }
    }
    nloc = mine > 0u ? mine : 1u; nx = cnt > 0u ? cnt : 1u;
}
__device__ __forceinline__ void xcd_barrier(const XcdBarrier& b) {
    asm volatile("s_waitcnt vmcnt(0)" ::: "memory");
    __syncthreads();
    if (threadIdx.x == 0) {
        unsigned* bar = b.bar;
        __builtin_amdgcn_s_waitcnt(0);
        unsigned nloc = b.st[0], nx = b.st[1];
        if (nloc == 0u) { xcd_barrier_complete(bar, b.x, nloc, nx); b.st[0] = nloc; b.st[1] = nx; }
        const unsigned old = xb_add(&bar[XB_XSUB(b.x)], 1u);
        const unsigned gen = old / nloc;
        if (old + 1u == (gen + 1u) * nloc) {
            __builtin_amdgcn_fence(__ATOMIC_RELEASE, "agent");
            asm volatile("s_waitcnt vmcnt(0)" ::: "memory");
            const unsigned og = xb_add(&bar[XB_TOP], 1u);
            const unsigned tg = og / nx;
            if (og + 1u == (tg + 1u) * nx) xb_add(&bar[XB_TOPGEN], 1u);
            else XB_SPIN(xb_ld(&bar[XB_TOPGEN]) == tg, bar);
            __builtin_amdgcn_fence(__ATOMIC_ACQUIRE, "agent");
            xb_add(&bar[XB_XGEN(b.x)], 1u);
            asm volatile("s_waitcnt vmcnt(0)" ::: "memory");
        } else {
            XB_SPIN(xb_ld(&bar[XB_XGEN(b.x)]) == gen, bar);
            __builtin_amdgcn_fence(__ATOMIC_ACQUIRE, "agent");
            asm volatile("s_waitcnt vmcnt(0)" ::: "memory");
        }
    }
    __syncthreads();
}

typedef unsigned short bf16_t;
typedef float f32x4 __attribute__((ext_vector_type(4)));
typedef unsigned u32x4 __attribute__((ext_vector_type(4)));
using pg8::cvt_pk_bf16;

struct Params {
    const float* x_prompt; const float* x_sample;
    const float* ck_cmp; const float* cv_cmp; const float* ck_sel; const float* cv_sel; const float* ck_win; const float* cv_win;
    const int* page_table;
    const float* norm_g; const float* w_in;
    const float* ck_w1; const float* ck_b1; const float* ck_w2; const float* ck_b2;
    const float* cv_w1; const float* cv_b1; const float* cv_w2; const float* cv_b2;
    const float* v_norm_g; const float* v_norm_b; const float* w_spatial; const float* b_spatial;
    const float* w_pa; const float* w_pb; const float* w_o; const float* final_g;
    float* out;
    unsigned* bar;
    float* rope;
    bf16_t* hbf;
    bf16_t* winT;
    bf16_t* wpaT;
    bf16_t* wpbT;
    bf16_t* woT;
    bf16_t* w1T;
    bf16_t* projbf;
    bf16_t* cmpA;
    float* Z;
    float* kc_p; float* vc_p; float* kc_s; float* vc_s;
    float* vn;
    bf16_t* a1bf;
    bf16_t* a2bf;
    float* msamp;
};

__device__ __forceinline__ float bf2f(unsigned short b) { return __uint_as_float(((unsigned)b) << 16); }
__device__ __forceinline__ float bflo(unsigned w) { return __uint_as_float(w << 16); }
__device__ __forceinline__ float bfhi(unsigned w) { return __uint_as_float(w & 0xffff0000u); }
__device__ __forceinline__ bf16_t f2bf(float f) { unsigned u = __float_as_uint(f); u += 0x7FFFu + ((u >> 16) & 1u); return (bf16_t)(u >> 16); }
__device__ __forceinline__ float gelu_tanh(float x) {
    const float c = 0.7978845608028654f;
    const float u = c * (x + 0.044715f * x * x * x);
    return 0.5f * x * (1.0f + tanhf(u));
}
__device__ __forceinline__ float sigmoidf_(float x) { return 1.0f / (1.0f + expf(-x)); }
__device__ __forceinline__ float siluf_(float x) { return x * sigmoidf_(x); }
__device__ __forceinline__ float wave_sum(float v) {
#pragma unroll
    for (int o = 32; o > 0; o >>= 1) v += __shfl_xor(v, o);
    return v;
}
__device__ __forceinline__ float wave_max(float v) {
#pragma unroll
    for (int o = 32; o > 0; o >>= 1) v = fmaxf(v, __shfl_xor(v, o));
    return v;
}
__device__ __forceinline__ const float* xrow(const Params& p, int r) {
    return r < MP ? p.x_prompt + (size_t)r * 1024 : p.x_sample + (size_t)(r - MP) * 1024;
}
__device__ __forceinline__ int row_pos(int r) { return r < MP ? (r & (SEQ - 1)) : PAST_LEN + ((r - MP) & 3); }

template <class AL, class BL, class EP>
__device__ __forceinline__ void sgemm_tiles(int M, int N, int K, const AL& al, const BL& bl, const EP& ep, int bid, int nblk, float* lds) {
    const int tid0_ = tid_opaque(); const int half = tid0_ >> 8, tid = tid0_ & 255, tx = tid & 15, ty = tid >> 4;
    const int tm = (M + 63) / 64, tn = (N + 63) / 64, nt = tm * tn;
    float (*As)[68] = (float (*)[68])(lds + half * 2176);
    float (*Bs)[68] = (float (*)[68])(lds + half * 2176 + 16 * 68);
    for (int tile0 = bid * 2; tile0 < nt; tile0 += nblk * 2) {
        const int tile = tile0 + half;
        const bool valid = tile < nt;
        const int m0 = (tile / tn) * 64, n0 = (tile % tn) * 64;
        float acc[4][4];
#pragma unroll
        for (int i = 0; i < 4; ++i)
#pragma unroll
            for (int j = 0; j < 4; ++j) acc[i][j] = 0.f;
        for (int k0 = 0; k0 < K; k0 += 16) {
            {
                const int r = tid >> 2, kq = (tid & 3) * 4;
                float4 v = make_float4(0.f, 0.f, 0.f, 0.f);
                if (valid && m0 + r < M) v = al(m0 + r, k0 + kq, n0);
                As[kq + 0][r] = v.x; As[kq + 1][r] = v.y; As[kq + 2][r] = v.z; As[kq + 3][r] = v.w;
            }
            {
                const int kk = tid >> 4, c = (tid & 15) * 4;
                float4 v = make_float4(0.f, 0.f, 0.f, 0.f);
                if (valid && n0 + c < N) v = bl(k0 + kk, n0 + c, m0);
                *(float4*)&Bs[kk][c] = v;
            }
            __syncthreads();
#pragma unroll
            for (int kk = 0; kk < 16; ++kk) {
                const float4 a = *(const float4*)&As[kk][ty * 4];
                const float4 b = *(const float4*)&Bs[kk][tx * 4];
                acc[0][0] += a.x * b.x; acc[0][1] += a.x * b.y; acc[0][2] += a.x * b.z; acc[0][3] += a.x * b.w;
                acc[1][0] += a.y * b.x; acc[1][1] += a.y * b.y; acc[1][2] += a.y * b.z; acc[1][3] += a.y * b.w;
                acc[2][0] += a.z * b.x; acc[2][1] += a.z * b.y; acc[2][2] += a.z * b.z; acc[2][3] += a.z * b.w;
                acc[3][0] += a.w * b.x; acc[3][1] += a.w * b.y; acc[3][2] += a.w * b.z; acc[3][3] += a.w * b.w;
            }
            __syncthreads();
        }
        if (valid) {
#pragma unroll
            for (int i = 0; i < 4; ++i) {
                const int row = m0 + ty * 4 + i, col = n0 + tx * 4;
                if (row < M && col < N) ep(row, col, make_float4(acc[i][0], acc[i][1], acc[i][2], acc[i][3]));
            }
        }
    }
}
__device__ __forceinline__ float4 ld_bf4(const bf16_t* p) {
    const uint2 w = *(const uint2*)p;
    return make_float4(bflo(w.x), bfhi(w.x), bflo(w.y), bfhi(w.y));
}

__device__ __forceinline__ void transpose_to_bf16(const float* src, int lsrc, int K, int N, int Npad, bf16_t* dst, int ldd, int bid, int nblk, float* lds) {
    const int tid = tid_opaque();
    const int tk = K / 64, tn = Npad / 64;
    float (*T)[65] = (float (*)[65])lds;
    for (int tile = bid; tile < tk * tn; tile += nblk) {
        const int k0 = (tile % tk) * 64, n0 = (tile / tk) * 64;
#pragma unroll
        for (int i = 0; i < 2; ++i) {
            const int kk = (tid >> 4) + i * 32, c = (tid & 15) * 4;
            float4 v = make_float4(0.f, 0.f, 0.f, 0.f);
            if (n0 + c < N) v = *(const float4*)(src + (size_t)(k0 + kk) * lsrc + n0 + c);
            T[kk][c + 0] = v.x; T[kk][c + 1] = v.y; T[kk][c + 2] = v.z; T[kk][c + 3] = v.w;
        }
        __syncthreads();
        {
            const int n = tid >> 3, kq = (tid & 7) * 8;
            u32x4 w;
            w.x = cvt_pk_bf16(T[kq + 0][n], T[kq + 1][n]); w.y = cvt_pk_bf16(T[kq + 2][n], T[kq + 3][n]);
            w.z = cvt_pk_bf16(T[kq + 4][n], T[kq + 5][n]); w.w = cvt_pk_bf16(T[kq + 6][n], T[kq + 7][n]);
            *(u32x4*)(dst + (size_t)(n0 + n) * ldd + k0 + kq) = w;
        }
        __syncthreads();
    }
}

__device__ __forceinline__ void phase_prep(const Params& p, int bid, int nblk, float* lds) {
    const int tid = tid_opaque(), lane = tid & 63, wid = tid >> 6;
    for (int i = bid * 512 + tid; i < ROPE_NPOS * 8; i += nblk * 512) {
        const int pos = i >> 3, f = i & 7;
        const double inv[8] = {1.0, 0.19392274474868576, 0.03760603093086393, 0.007292664737217109,
                               0.001414213562373095, 0.0002742481756762073, 5.318295896944988e-05, 1.031338537721246e-05};
        double invf = inv[0];
#pragma unroll
        for (int j = 1; j < 8; ++j) invf = (f == j) ? inv[j] : invf;
        const double a = (double)pos * invf * 0.15915494309189535;
        const float rf = (float)((a - rint(a)) * 6.283185307179586);
        p.rope[i * 2 + 0] = cosf(rf);
        p.rope[i * 2 + 1] = sinf(rf);
    }
    for (int r = bid * 8 + wid; r < MPAD; r += nblk * 8) {
        bf16_t* dst = p.hbf + (size_t)r * 1024;
        if (r >= MT) {
#pragma unroll
            for (int i = 0; i < 2; ++i) *(u32x4*)(dst + (i * 64 + lane) * 8) = (u32x4){0u, 0u, 0u, 0u};
            continue;
        }
        const float* x = xrow(p, r);
        float4 v[4]; float ss = 0.f;
#pragma unroll
        for (int i = 0; i < 4; ++i) {
            v[i] = *(const float4*)(x + (i * 64 + lane) * 4);
            ss += v[i].x * v[i].x + v[i].y * v[i].y + v[i].z * v[i].z + v[i].w * v[i].w;
        }
        ss = wave_sum(ss);
        const float rs = rsqrtf(ss * (1.0f / 1024.0f) + 1e-6f);
#pragma unroll
        for (int i = 0; i < 4; ++i) {
            const float4 g = *(const float4*)(p.norm_g + (i * 64 + lane) * 4);
            uint2 w;
            w.x = cvt_pk_bf16(v[i].x * rs * g.x, v[i].y * rs * g.y); w.y = cvt_pk_bf16(v[i].z * rs * g.z, v[i].w * rs * g.w);
            *(uint2*)(dst + (i * 64 + lane) * 4) = w;
        }
    }
    transpose_to_bf16(p.w_in, IN_WIDTH, 1024, IN_WIDTH, LDP, p.winT, 1024, bid, nblk, lds);
    transpose_to_bf16(p.w_pa, 1024, 512, 1024, 1024, p.wpaT, 512, bid, nblk, lds);
    transpose_to_bf16(p.w_pb, 1024, 512, 1024, 1024, p.wpbT, 512, bid, nblk, lds);
    transpose_to_bf16(p.w_o, 1024, 1024, 1024, 1024, p.woT, 1024, bid, nblk, lds);
    transpose_to_bf16(p.ck_w1, 128, 1024, 128, 128, p.w1T, 1024, bid, nblk, lds);
    transpose_to_bf16(p.ck_w1 + (size_t)1024 * 128, 128, 1024, 128, 128, p.w1T + (size_t)128 * 1024, 1024, bid, nblk, lds);
    transpose_to_bf16(p.cv_w1, 128, 1024, 128, 128, p.w1T + (size_t)256 * 1024, 1024, bid, nblk, lds);
    transpose_to_bf16(p.cv_w1 + (size_t)1024 * 128, 128, 1024, 128, 128, p.w1T + (size_t)384 * 1024, 1024, bid, nblk, lds);
    const int tot2 = DEC_BATCH * 508 * 32;
    for (int i = bid * 512 + tid; i < tot2; i += nblk * 512) {
        const int b = i / (508 * 32), rem = i % (508 * 32);
        const int j = rem >> 5, w = (rem & 31) * 4;
        *(float4*)(p.out + O_SKW + ((size_t)b * 512 + j) * 128 + w) = *(const float4*)(p.ck_win + ((size_t)b * 512 + j + 4) * 128 + w);
        *(float4*)(p.out + O_SVW + ((size_t)b * 512 + j) * 128 + w) = *(const float4*)(p.cv_win + ((size_t)b * 512 + j + 4) * 128 + w);
    }
    const int tot3 = 2 * DEC_BATCH * PAST_LEN * 16;
    for (int i = bid * 512 + tid; i < tot3; i += nblk * 512) {
        const int d8 = i & 7, g = (i >> 3) & 1, pos = (i >> 4) & (PAST_LEN - 1), b = (i >> 17) & 31, ten = i >> 22;
        const float* pool = ten ? p.cv_cmp : p.ck_cmp;
        const int phys = p.page_table[b * N_PAGES + (pos >> 7)];
        const float* s = pool + (((size_t)phys * 128 + (pos & 127)) * 2 + g) * 64 + d8 * 8;
        const float4 a = *(const float4*)s, c = *(const float4*)(s + 4);
        u32x4 w; w.x = cvt_pk_bf16(a.x, a.y); w.y = cvt_pk_bf16(a.z, a.w); w.z = cvt_pk_bf16(c.x, c.y); w.w = cvt_pk_bf16(c.z, c.w);
        *(u32x4*)(p.cmpA + ((size_t)ten * 32768 + (b * 2 + g) * 512 + (pos >> 4)) * 1024 + (pos & 15) * 64 + d8 * 8) = w;
    }
}

struct EpiProj {
    static constexpr bool PERM = true, AFTER_DRAIN = false;
    bf16_t* projbf; float* out; const float* rope; bf16_t* cmpA;
    __device__ __forceinline__ void operator()(const f32x4 (&acc)[2][2][4][2], const pg8::Unit& u, int wr, int wc, int fr, int fq) const {
        const int pn = u.pn;
#pragma unroll
        for (int ai = 0; ai < 2; ++ai)
#pragma unroll
            for (int m = 0; m < 4; ++m) {
                const int row = u.pm * 256 + ai * 128 + wr * 64 + m * 16 + fr;
                const int pos = row < MT ? row_pos(row) : 0;
#pragma unroll
                for (int bj = 0; bj < 2; ++bj) {
                    f32x4 v0 = acc[ai][bj][m][0], v1 = acc[ai][bj][m][1];
                    const int col0 = pn * 256 + bj * 128 + wc * 32 + 8 * fq;
                    const bool roped = (pn <= 1 || ((pn == 3 || pn == 4) && bj == 0)) && ((wc & 1) == 0);
                    if (roped) {
                        f32x4 q0, q1;
#pragma unroll
                        for (int i = 0; i < 4; ++i) { q0[i] = __shfl_xor(v0[i], 16); q1[i] = __shfl_xor(v1[i], 16); }
                        if (fq < 2) {
                            const float4* cs = (const float4*)(rope + (size_t)pos * 16);
                            const float4 c01 = cs[0], c23 = cs[1], c45 = cs[2], c67 = cs[3];
                            const float sg = fq == 0 ? -1.0f : 1.0f;
                            v0[0] = v0[0] * c01.x + sg * q0[0] * c01.y; v0[1] = v0[1] * c01.z + sg * q0[1] * c01.w;
                            v0[2] = v0[2] * c23.x + sg * q0[2] * c23.y; v0[3] = v0[3] * c23.z + sg * q0[3] * c23.w;
                            v1[0] = v1[0] * c45.x + sg * q1[0] * c45.y; v1[1] = v1[1] * c45.z + sg * q1[1] * c45.w;
                            v1[2] = v1[2] * c67.x + sg * q1[2] * c67.y; v1[3] = v1[3] * c67.z + sg * q1[3] * c67.w;
                        }
                    }
                    u32x4 w; w.x = cvt_pk_bf16(v0[0], v0[1]); w.y = cvt_pk_bf16(v0[2], v0[3]); w.z = cvt_pk_bf16(v1[0], v1[1]); w.w = cvt_pk_bf16(v1[2], v1[3]);
                    *(u32x4*)(projbf + (size_t)row * LDP + col0) = w;
                    if (pn >= 2 && pn <= 4 && row < MT) {
                        const int cc = col0 - 512, sec = cc >> 7, wv = cc & 127;
                        float* dst = nullptr;
                        if (row < MP) {
                            const int b = row >> 12, t = row & 4095;
                            if (sec < 4) dst = out + O_PKC + (size_t)sec * MP * 128 + (size_t)row * 128 + wv;
                            else if (t >= SEQ - 512) dst = out + (sec == 4 ? O_PKW : O_PVW) + ((size_t)b * 512 + (t - (SEQ - 512))) * 128 + wv;
                            if (sec < 2) {
                                const int g = wv >> 6, d = wv & 63;
                                *(u32x4*)(cmpA + ((size_t)(65536 + sec * 2048 + (b * 2 + g) * 256 + (t >> 4))) * 1024 + (t & 15) * 64 + d) = w;
                            }
                        } else {
                            const int rs = row - MP, b = rs >> 2, t = rs & 3;
                            if (sec < 4) dst = out + O_SKC + (size_t)sec * MS * 128 + (size_t)rs * 128 + wv;
                            else dst = out + (sec == 4 ? O_SKW : O_SVW) + ((size_t)b * 512 + 508 + t) * 128 + wv;
                        }
                        if (dst) { *(f32x4*)dst = v0; *(f32x4*)(dst + 4) = v1; }
                    }
                }
            }
    }
};

struct CmpOrder {
    int G, c;
    __device__ bool next(int i, pg8::Unit& u) const {
        const int L = i * G + c; if (L >= CMPA_ROWS / 256) return false;
        u.pm = L; u.pn = (L < 128) ? 0 : (L < 256) ? 1 : (L < 264) ? 0 : 1; return true;
    }
    __device__ __forceinline__ void a_ready(const pg8::Unit&) const {}
    __device__ __forceinline__ void done(const pg8::Unit&) const {}
};
struct EpiZ {
    static constexpr bool PERM = false, AFTER_DRAIN = false;
    float* Z;
    __device__ __forceinline__ void operator()(const f32x4 (&acc)[2][2][4][2], const pg8::Unit& u, int wr, int wc, int fr, int fq) const {
#pragma unroll
        for (int ai = 0; ai < 2; ++ai)
#pragma unroll
            for (int m = 0; m < 4; ++m) {
                float* rowp = Z + (size_t)(u.pm * 256 + ai * 128 + wr * 64 + m * 16 + fr) * 256 + wc * 32 + 4 * fq;
#pragma unroll
                for (int bj = 0; bj < 2; ++bj)
#pragma unroll
                    for (int n = 0; n < 2; ++n) *(f32x4*)(rowp + bj * 128 + n * 16) = acc[ai][bj][m][n];
            }
    }
};

__device__ __forceinline__ void phase_vn(const Params& p, int bid, int nblk) {
    const int tid = tid_opaque(), lane = tid & 63, wid = tid >> 6;
    for (int r = bid * 8 + wid; r < MT; r += nblk * 8) {
        const u32x4 w = *(const u32x4*)(p.projbf + (size_t)r * LDP + C_V + lane * 8);
        float ge[8];
        ge[0] = gelu_tanh(bflo(w.x)); ge[1] = gelu_tanh(bfhi(w.x)); ge[2] = gelu_tanh(bflo(w.y)); ge[3] = gelu_tanh(bfhi(w.y));
        ge[4] = gelu_tanh(bflo(w.z)); ge[5] = gelu_tanh(bfhi(w.z)); ge[6] = gelu_tanh(bflo(w.w)); ge[7] = gelu_tanh(bfhi(w.w));
        float s = 0.f;
#pragma unroll
        for (int i = 0; i < 8; ++i) s += ge[i];
        const float mu = wave_sum(s) * (1.0f / 512.0f);
        float q = 0.f;
#pragma unroll
        for (int i = 0; i < 8; ++i) { const float d = ge[i] - mu; q += d * d; }
        const float rstd = rsqrtf(wave_sum(q) * (1.0f / 512.0f) + 1e-6f);
        float y[8];
#pragma unroll
        for (int i = 0; i < 8; ++i) { const int c = lane * 8 + i; y[i] = (ge[i] - mu) * rstd * p.v_norm_g[c] + p.v_norm_b[c]; }
        float* dst = p.vn + (size_t)r * 512 + lane * 8;
        *(float4*)dst = make_float4(y[0], y[1], y[2], y[3]); *(float4*)(dst + 4) = make_float4(y[4], y[5], y[6], y[7]);
        if (r >= MP) {
            float* d2 = p.out + O_SVCH + (size_t)(r - MP) * 512 + lane * 8;
            *(float4*)d2 = make_float4(y[0], y[1], y[2], y[3]); *(float4*)(d2 + 4) = make_float4(y[4], y[5], y[6], y[7]);
        }
    }
}

template <bool ISV, bool SAMP>
__device__ __forceinline__ void phase_cmp2_v(const Params& p, int bid, int nblk, float* lds) {
    const int tid = tid_opaque(), lane = tid & 63, wid = tid >> 6;
    float* hidw = lds + wid * 128;
    constexpr int ncmp = SAMP ? NCMP_S : NCMP_P, nseg = SAMP ? 512 : 256;
    const int total = (SAMP ? DEC_BATCH : BATCH) * ncmp * 2;
    const float* b1 = ISV ? p.cv_b1 : p.ck_b1; const float* w2 = ISV ? p.cv_w2 : p.ck_w2; const float* b2 = ISV ? p.cv_b2 : p.ck_b2;
    float* outp = ISV ? (SAMP ? p.vc_s : p.vc_p) : (SAMP ? p.kc_s : p.kc_p);
    for (int rc = bid * 8 + wid; rc < total; rc += nblk * 8) {
        const int g = rc & 1, bc = rc >> 1, b = bc / ncmp, c = bc - b * ncmp;
        const size_t zrow = (size_t)(SAMP ? (ISV ? 32768 : 0) : 65536 + (ISV ? 2048 : 0)) + (size_t)(b * 2 + g) * nseg + c;
        const float* z0 = p.Z + zrow * 256;
        const float* z1 = p.Z + (zrow + 1) * 256 + 128;
        hidw[lane] = gelu_tanh(z0[lane] + z1[lane] + b1[lane]);
        hidw[lane + 64] = gelu_tanh(z0[lane + 64] + z1[lane + 64] + b1[lane + 64]);
        float acc = b2[lane];
#pragma unroll 8
        for (int h = 0; h < 128; ++h) acc += hidw[h] * w2[h * 64 + lane];
        if (!ISV) {
            const int pos = c * 16 + 31;
            const float other = __shfl_xor(acc, 8);
            if (lane < 16) {
                const int d = lane & 7;
                const float cs = p.rope[(pos * 8 + d) * 2], sn = p.rope[(pos * 8 + d) * 2 + 1];
                acc = lane < 8 ? acc * cs - other * sn : acc * cs + other * sn;
            }
        }
        outp[(size_t)rc * 64 + lane] = acc;
    }
}
__device__ __forceinline__ void phase_cmp2(const Params& p, int bid, int nblk, float* lds) {
    phase_cmp2_v<false, true>(p, bid, nblk, lds); phase_cmp2_v<true, true>(p, bid, nblk, lds);
    phase_cmp2_v<false, false>(p, bid, nblk, lds); phase_cmp2_v<true, false>(p, bid, nblk, lds);
}

__device__ __forceinline__ void phase_spatial(const Params& p, int bid, int nblk, float* lds) {
    const float* vn = p.vn; const bf16_t* proj = p.projbf; bf16_t* a2 = p.a2bf;
#pragma unroll 1
    for (int g = 0; g < 4; ++g) {
        const float* W = p.w_spatial + (size_t)g * 128 * 128; const float* bs = p.b_spatial + g * 128;
        auto al = [=](int row, int k, int) {
            const int t = row & 127;
            float4 v = *(const float4*)(W + (size_t)t * 128 + k);
            if (k + 0 > t) v.x = 0.f;
            if (k + 1 > t) v.y = 0.f;
            if (k + 2 > t) v.z = 0.f;
            if (k + 3 > t) v.w = 0.f;
            return v;
        };
        auto bl = [=](int k, int col, int m0) { return *(const float4*)(vn + (size_t)((m0 & ~127) + k) * 512 + g * 128 + col); };
        auto ep = [=](int row, int col, float4 a) {
            const int t = row & 127; const float bb = bs[t];
            const float4 u = ld_bf4(proj + (size_t)row * LDP + C_U + g * 128 + col);
            const float4 z = ld_bf4(proj + (size_t)row * LDP + C_ZB + g * 128 + col);
            uint2 w;
            w.x = cvt_pk_bf16(gelu_tanh(u.x) * (a.x + bb) * siluf_(z.x), gelu_tanh(u.y) * (a.y + bb) * siluf_(z.y));
            w.y = cvt_pk_bf16(gelu_tanh(u.z) * (a.z + bb) * siluf_(z.z), gelu_tanh(u.w) * (a.w + bb) * siluf_(z.w));
            *(uint2*)(a2 + (size_t)row * 512 + g * 128 + col) = w;
        };
        sgemm_tiles(MP, 128, 128, al, bl, ep, bid, nblk, lds);
    }
    for (int i = bid * 512 + tid_opaque(); i < MS * 512; i += nblk * 512) {
        const int rs = i >> 9, c = i & 511, g = c >> 7, t = rs & 3, r = MP + rs;
        float acc = p.b_spatial[g * 128 + t];
        for (int s = 0; s <= t; ++s) acc += p.w_spatial[((size_t)g * 128 + t) * 128 + s] * vn[(size_t)(r - t + s) * 512 + c];
        const float u = bf2f(proj[(size_t)r * LDP + C_U + c]), z = bf2f(proj[(size_t)r * LDP + C_ZB + c]);
        a2[(size_t)r * 512 + c] = f2bf(gelu_tanh(u) * acc * siluf_(z));
    }
}

__device__ __forceinline__ float dot64_f32(const float* q_lds, const float* krow) {
    float s = 0.f;
#pragma unroll
    for (int i = 0; i < 16; ++i) {
        const float4 kv = *(const float4*)(krow + i * 4);
        const float4 qv = *(const float4*)(q_lds + i * 4);
        s += kv.x * qv.x + kv.y * qv.y + kv.z * qv.z + kv.w * qv.w;
    }
    return s;
}
__device__ __forceinline__ float dot64_bf(const float* q_lds, const bf16_t* krow) {
    float s = 0.f;
#pragma unroll
    for (int i = 0; i < 8; ++i) {
        const u32x4 w = *(const u32x4*)(krow + i * 8);
        const float4 q0 = *(const float4*)(q_lds + i * 8), q1 = *(const float4*)(q_lds + i * 8 + 4);
        s += bflo(w.x) * q0.x + bfhi(w.x) * q0.y + bflo(w.y) * q0.z + bfhi(w.y) * q0.w
           + bflo(w.z) * q1.x + bfhi(w.z) * q1.y + bflo(w.w) * q1.z + bfhi(w.w) * q1.w;
    }
    return s;
}
__device__ __forceinline__ void wave_softmax(float* sc, int n, int lane) {
    float m = -INFINITY;
    for (int i = lane; i < n; i += 64) m = fmaxf(m, sc[i]);
    m = wave_max(m);
    float sum = 0.f;
    for (int i = lane; i < n; i += 64) { const float e = (sc[i] == -INFINITY) ? 0.f : expf(sc[i] - m); sc[i] = e; sum += e; }
    sum = wave_sum(sum);
    const float inv = 1.0f / sum;
    for (int i = lane; i < n; i += 64) sc[i] *= inv;
}

template <bool SAMP>
__device__ __forceinline__ void attn_units(const Params& p, int bid, int nblk, float* lds) {
    const int tid = tid_opaque(), lane = tid & 63, wv = tid >> 6, half = wv >> 2, w = wv & 3;
    float* sc = lds + wv * 1024;
    float* qs = lds + 8192 + wv * 64;
    float* score = lds + 8192 + 512 + half * 192;
    int* selidx = (int*)(lds + 8192 + 512 + 384) + half * 16;
    const int nunits = SAMP ? MS * 2 : MP * 2;
    const int ncmp = SAMP ? NCMP_S : NCMP_P, nsel = SAMP ? NSEL_S : NSEL_P;
    for (int u0 = bid * 2; u0 < nunits; u0 += nblk * 2) {
        const int u = u0 + half;
        const bool valid = u < nunits;
        const int r = (SAMP ? MP : 0) + (valid ? (u >> 1) : 0), g = u & 1;
        const int b = SAMP ? ((r - MP) >> 2) : (r >> 12);
        const int qpos = row_pos(r);
        const int head = g * 4 + w;
        const bf16_t* prow = p.projbf + (size_t)r * LDP;
        qs[lane] = bf2f(prow[C_Q + head * 64 + lane]) * 0.125f;
        int nvis = qpos >= 31 ? ((qpos - 31) >> 4) + 1 : 0;
        if (nvis > ncmp) nvis = ncmp;
        const float* kc = (SAMP ? p.kc_s : p.kc_p) + ((size_t)b * ncmp * 2 + g) * 64;
        const float* vc = (SAMP ? p.vc_s : p.vc_p) + ((size_t)b * ncmp * 2 + g) * 64;
        for (int c = lane; c < 512; c += 64) sc[c] = (c < nvis) ? dot64_f32(qs, kc + (size_t)c * 128) : -INFINITY;
        float o_cmp = 0.f;
        if (nvis > 0) {
            wave_softmax(sc, 512, lane);
            for (int c = 0; c < nvis; ++c) o_cmp += sc[c] * vc[(size_t)c * 128 + lane];
        } else {
            for (int c = lane; c < 512; c += 64) sc[c] = 0.f;
        }
        __syncthreads();
        {
            const int hl = tid & 255;
            if (hl < nsel) {
                const int s = hl;
                float imp = 0.f;
#pragma unroll
                for (int ww = 0; ww < 4; ++ww) {
                    const float* pc = lds + (half * 4 + ww) * 1024;
                    const int c0 = 4 * s;
                    float a = 0.f;
                    if (c0 - 1 >= 0 && c0 - 1 < nvis) a += 0.5f * pc[c0 - 1];
                    if (c0 < nvis) a += pc[c0];
                    if (c0 + 1 < nvis) a += pc[c0 + 1];
                    if (c0 + 2 < nvis) a += pc[c0 + 2];
                    if (c0 + 3 < nvis) a += 0.5f * pc[c0 + 3];
                    imp += a;
                }
                const int cur = qpos >> 6;
                const bool vld = s <= cur;
                const bool forced = (vld && s > cur - 2) || s < 1;
                score[s] = forced ? 1e30f : (vld ? imp : -1e30f);
            }
        }
        __syncthreads();
        if (w == 0) {
            float v0 = lane < nsel ? score[lane] : -3e38f;
            float v1 = lane + 64 < nsel ? score[lane + 64] : -3e38f;
            float v2 = lane + 128 < nsel ? score[lane + 128] : -3e38f;
            for (int n = 0; n < 16; ++n) {
                float bv = v0; int bi = lane;
                if (v1 > bv) { bv = v1; bi = lane + 64; }
                if (v2 > bv) { bv = v2; bi = lane + 128; }
#pragma unroll
                for (int o = 32; o > 0; o >>= 1) {
                    const float ov = __shfl_xor(bv, o); const int oi = __shfl_xor(bi, o);
                    if (ov > bv || (ov == bv && oi < bi)) { bv = ov; bi = oi; }
                }
                if (lane == 0) selidx[n] = bi;
                if (bi == lane) v0 = -3e38f;
                if (bi == lane + 64) v1 = -3e38f;
                if (bi == lane + 128) v2 = -3e38f;
            }
        }
        __syncthreads();
        for (int n = 0; n < 16; ++n) {
            const int blk = selidx[n];
            const int kp = blk * 64 + lane;
            float s = -INFINITY;
            if (kp <= qpos) {
                if (!SAMP) s = dot64_bf(qs, p.projbf + (size_t)(b * SEQ + kp) * LDP + C_KS + g * 64);
                else if (blk < 128) s = dot64_f32(qs, p.ck_sel + (((size_t)p.page_table[b * N_PAGES + (blk >> 1)] * 128 + (blk & 1) * 64 + lane) * 2 + g) * 64);
                else if (lane < 4) s = dot64_bf(qs, p.projbf + (size_t)(MP + b * 4 + lane) * LDP + C_KS + g * 64);
            }
            sc[n * 64 + lane] = s;
        }
        wave_softmax(sc, 1024, lane);
        float o_sel = 0.f;
        for (int n = 0; n < 16; ++n) {
            const int blk = selidx[n];
            if (blk * 64 > qpos) continue;
            if (!SAMP) {
                const bf16_t* vb = p.projbf + (size_t)(b * SEQ + blk * 64) * LDP + C_VS + g * 64 + lane;
                for (int k = 0; k < 64; ++k) o_sel += sc[n * 64 + k] * bf2f(vb[(size_t)k * LDP]);
            } else if (blk < 128) {
                const float* vb = p.cv_sel + (((size_t)p.page_table[b * N_PAGES + (blk >> 1)] * 128 + (blk & 1) * 64) * 2 + g) * 64 + lane;
                for (int k = 0; k < 64; ++k) o_sel += sc[n * 64 + k] * vb[(size_t)k * 128];
            } else {
                const bf16_t* vb = p.projbf + (size_t)(MP + b * 4) * LDP + C_VS + g * 64 + lane;
                for (int k = 0; k < 4; ++k) o_sel += sc[n * 64 + k] * bf2f(vb[(size_t)k * LDP]);
            }
        }
        for (int i = lane; i < 512; i += 64) {
            const int kp = qpos - 511 + i;
            float s = -INFINITY;
            if (kp >= 0) {
                if (!SAMP) s = dot64_bf(qs, p.projbf + (size_t)(b * SEQ + kp) * LDP + C_KW + g * 64);
                else if (kp < PAST_LEN) s = dot64_f32(qs, p.ck_win + (((size_t)b * 512 + (kp - (PAST_LEN - 512))) * 2 + g) * 64);
                else s = dot64_bf(qs, p.projbf + (size_t)(MP + b * 4 + (kp - PAST_LEN)) * LDP + C_KW + g * 64);
            }
            sc[i] = s;
        }
        wave_softmax(sc, 512, lane);
        float o_win = 0.f;
        for (int i = 0; i < 512; ++i) {
            const int kp = qpos - 511 + i;
            if (kp < 0) continue;
            float v;
            if (!SAMP) v = bf2f(p.projbf[(size_t)(b * SEQ + kp) * LDP + C_VW + g * 64 + lane]);
            else if (kp < PAST_LEN) v = p.cv_win[(((size_t)b * 512 + (kp - (PAST_LEN - 512))) * 2 + g) * 64 + lane];
            else v = bf2f(p.projbf[(size_t)(MP + b * 4 + (kp - PAST_LEN)) * LDP + C_VW + g * 64 + lane]);
            o_win += sc[i] * v;
        }
        const float g0 = sigmoidf_(bf2f(prow[C_GL + head * 3 + 0])), g1 = sigmoidf_(bf2f(prow[C_GL + head * 3 + 1])), g2 = sigmoidf_(bf2f(prow[C_GL + head * 3 + 2]));
        const float o = g0 * o_cmp + g1 * o_sel + g2 * o_win;
        if (valid) p.a1bf[(size_t)r * 512 + head * 64 + lane] = f2bf(o * siluf_(bf2f(prow[C_ZA + head * 64 + lane])));
        __syncthreads();
    }
}

struct EpiMerge1 {
    static constexpr bool PERM = true, AFTER_DRAIN = false;
    const bf16_t* projbf; float* tmp;
    __device__ __forceinline__ void operator()(const f32x4 (&acc)[2][2][4][2], const pg8::Unit& u, int wr, int wc, int fr, int fq) const {
#pragma unroll
        for (int ai = 0; ai < 2; ++ai)
#pragma unroll
            for (int m = 0; m < 4; ++m) {
                const int row = u.pm * 256 + ai * 128 + wr * 64 + m * 16 + fr;
#pragma unroll
                for (int bj = 0; bj < 2; ++bj) {
                    const int col0 = u.pn * 256 + bj * 128 + wc * 32 + 8 * fq;
                    const u32x4 rw = *(const u32x4*)(projbf + (size_t)row * LDP + C_RA + col0);
                    const f32x4 v0 = acc[ai][bj][m][0], v1 = acc[ai][bj][m][1];
                    f32x4 o0, o1;
                    o0[0] = sigmoidf_(bflo(rw.x)) * v0[0]; o0[1] = sigmoidf_(bfhi(rw.x)) * v0[1]; o0[2] = sigmoidf_(bflo(rw.y)) * v0[2]; o0[3] = sigmoidf_(bfhi(rw.y)) * v0[3];
                    o1[0] = sigmoidf_(bflo(rw.z)) * v1[0]; o1[1] = sigmoidf_(bfhi(rw.z)) * v1[1]; o1[2] = sigmoidf_(bflo(rw.w)) * v1[2]; o1[3] = sigmoidf_(bfhi(rw.w)) * v1[3];
                    float* dst = tmp + (size_t)row * 1024 + col0;
                    *(f32x4*)dst = o0; *(f32x4*)(dst + 4) = o1;
                }
            }
    }
};
struct EpiMerge2 {
    static constexpr bool PERM = true, AFTER_DRAIN = false;
    const bf16_t* projbf; const float* tmp; bf16_t* mbf;
    __device__ __forceinline__ void operator()(const f32x4 (&acc)[2][2][4][2], const pg8::Unit& u, int wr, int wc, int fr, int fq) const {
#pragma unroll
        for (int ai = 0; ai < 2; ++ai)
#pragma unroll
            for (int m = 0; m < 4; ++m) {
                const int row = u.pm * 256 + ai * 128 + wr * 64 + m * 16 + fr;
#pragma unroll
                for (int bj = 0; bj < 2; ++bj) {
                    const int col0 = u.pn * 256 + bj * 128 + wc * 32 + 8 * fq;
                    const u32x4 rw = *(const u32x4*)(projbf + (size_t)row * LDP + C_RB + col0);
                    const float* src = tmp + (size_t)row * 1024 + col0;
                    const f32x4 t0 = *(const f32x4*)src, t1 = *(const f32x4*)(src + 4);
                    const f32x4 v0 = acc[ai][bj][m][0], v1 = acc[ai][bj][m][1];
                    u32x4 w;
                    w.x = cvt_pk_bf16(t0[0] + sigmoidf_(bflo(rw.x)) * v0[0], t0[1] + sigmoidf_(bfhi(rw.x)) * v0[1]);
                    w.y = cvt_pk_bf16(t0[2] + sigmoidf_(bflo(rw.y)) * v0[2], t0[3] + sigmoidf_(bfhi(rw.y)) * v0[3]);
                    w.z = cvt_pk_bf16(t1[0] + sigmoidf_(bflo(rw.z)) * v1[0], t1[1] + sigmoidf_(bfhi(rw.z)) * v1[1]);
                    w.w = cvt_pk_bf16(t1[2] + sigmoidf_(bflo(rw.w)) * v1[2], t1[3] + sigmoidf_(bfhi(rw.w)) * v1[3]);
                    *(u32x4*)(mbf + (size_t)row * 1024 + col0) = w;
                }
            }
    }
};
struct EpiWo {
    static constexpr bool PERM = false, AFTER_DRAIN = false;
    const float* x; float* out;
    __device__ __forceinline__ void operator()(const f32x4 (&acc)[2][2][4][2], const pg8::Unit& u, int wr, int wc, int fr, int fq) const {
#pragma unroll
        for (int ai = 0; ai < 2; ++ai)
#pragma unroll
            for (int m = 0; m < 4; ++m) {
                const size_t ro = (size_t)(u.pm * 256 + ai * 128 + wr * 64 + m * 16 + fr) * 1024 + u.pn * 256 + wc * 32 + 4 * fq;
#pragma unroll
                for (int bj = 0; bj < 2; ++bj)
#pragma unroll
                    for (int n = 0; n < 2; ++n) {
                        const f32x4 xv = *(const f32x4*)(x + ro + bj * 128 + n * 16);
                        *(f32x4*)(out + ro + bj * 128 + n * 16) = xv + acc[ai][bj][m][n];
                    }
            }
    }
};
__device__ __forceinline__ void phase_merge_sample(const Params& p, int bid, int nblk, float* lds, int pass) {
    const bf16_t* proj = p.projbf; float* mg = p.msamp;
    if (pass == 0) {
        const bf16_t* a1 = p.a1bf; const float* w = p.w_pa;
        auto al = [=](int row, int k, int) { return ld_bf4(a1 + (size_t)(MP + row) * 512 + k); };
        auto bl = [=](int k, int col, int) { return *(const float4*)(w + (size_t)k * 1024 + col); };
        auto ep = [=](int row, int col, float4 a) {
            const float4 r = ld_bf4(proj + (size_t)(MP + row) * LDP + C_RA + col);
            *(float4*)(mg + (size_t)row * 1024 + col) = make_float4(sigmoidf_(r.x) * a.x, sigmoidf_(r.y) * a.y, sigmoidf_(r.z) * a.z, sigmoidf_(r.w) * a.w);
        };
        sgemm_tiles(MS, 1024, 512, al, bl, ep, bid, nblk, lds);
    } else {
        const bf16_t* a2 = p.a2bf; const float* w = p.w_pb;
        auto al = [=](int row, int k, int) { return ld_bf4(a2 + (size_t)(MP + row) * 512 + k); };
        auto bl = [=](int k, int col, int) { return *(const float4*)(w + (size_t)k * 1024 + col); };
        auto ep = [=](int row, int col, float4 a) {
            const float4 r = ld_bf4(proj + (size_t)(MP + row) * LDP + C_RB + col);
            float4 m = *(float4*)(mg + (size_t)row * 1024 + col);
            m.x += sigmoidf_(r.x) * a.x; m.y += sigmoidf_(r.y) * a.y; m.z += sigmoidf_(r.z) * a.z; m.w += sigmoidf_(r.w) * a.w;
            *(float4*)(mg + (size_t)row * 1024 + col) = m;
        };
        sgemm_tiles(MS, 1024, 512, al, bl, ep, bid, nblk, lds);
    }
}
__device__ __forceinline__ void phase_wo_sample(const Params& p, int bid, int nblk, float* lds) {
    const float* mg = p.msamp; const float* w = p.w_o; float* out = p.out + O_YS; const float* xs = p.x_sample;
    auto al = [=](int row, int k, int) { return *(const float4*)(mg + (size_t)row * 1024 + k); };
    auto bl = [=](int k, int col, int) { return *(const float4*)(w + (size_t)k * 1024 + col); };
    auto ep = [=](int row, int col, float4 a) {
        const float4 xv = *(const float4*)(xs + (size_t)row * 1024 + col);
        *(float4*)(out + (size_t)row * 1024 + col) = make_float4(xv.x + a.x, xv.y + a.y, xv.z + a.z, xv.w + a.w);
    };
    sgemm_tiles(MS, 1024, 1024, al, bl, ep, bid, nblk, lds);
}
__device__ __forceinline__ void phase_final(const Params& p, int bid, int nblk) {
    const int tid = tid_opaque(), lane = tid & 63, wid = tid >> 6;
    for (int r = bid * 8 + wid; r < MT; r += nblk * 8) {
        float* x = p.out + (size_t)r * 1024;
        float4 v[4]; float ss = 0.f;
#pragma unroll
        for (int i = 0; i < 4; ++i) {
            v[i] = *(const float4*)(x + (i * 64 + lane) * 4);
            ss += v[i].x * v[i].x + v[i].y * v[i].y + v[i].z * v[i].z + v[i].w * v[i].w;
        }
        ss = wave_sum(ss);
        const float rs = rsqrtf(ss * (1.0f / 1024.0f) + 1e-6f);
#pragma unroll
        for (int i = 0; i < 4; ++i) {
            const float4 g = *(const float4*)(p.final_g + (i * 64 + lane) * 4);
            float4 o;
            o.x = v[i].x * rs * g.x; o.y = v[i].y * rs * g.y; o.z = v[i].z * rs * g.z; o.w = v[i].w * rs * g.w;
            *(float4*)(x + (i * 64 + lane) * 4) = o;
        }
    }
}

typedef const __attribute__((address_space(4))) Params* KParamsPtr;
#if defined(__HIP_DEVICE_COMPILE__)
#define LOADP(P) KParamsPtr _kp = (KParamsPtr)__builtin_amdgcn_kernarg_segment_ptr(); asm volatile("" : "+s"(_kp)); const Params P = *_kp;
#else
#define LOADP(P) const Params P = p_unused;
#endif
__global__ void __launch_bounds__(512, 2) k_mega(Params p_unused) {
    extern __shared__ __attribute__((aligned(16))) unsigned char smem[];
    PG8_LAS unsigned char* ldsg = (PG8_LAS unsigned char*)smem;
    float* ldsf = (float*)smem;
    volatile LAS unsigned* xbw = (volatile LAS unsigned*)(ldsg + 131072);
    if (threadIdx.x == 0) { xbw[0] = 0u; xbw[1] = 0u; xbw[2] = 0u; xbw[3] = 0u; }
    __syncthreads();
    XcdBarrier xb;
    { LOADP(p); xb = xcd_barrier_post(p.bar, xbw); }
    const int bid = blockIdx.x, nblk = gridDim.x;

    { LOADP(p); phase_prep(p, bid, nblk, ldsf); }
#if USE_CG_SYNC
    cg::this_grid().sync();
#endif
    xcd_barrier(xb);
    {
        LOADP(p);
        pg8::Gemm g{p.hbf, p.winT, MPAD, LDP, 1024};
        pg8::StaticOrder S; S.init(MPAD, LDP, nblk, bid);
        EpiProj E{p.projbf, p.out, p.rope, p.cmpA};
        pg8::gemm_phase<EpiProj, pg8::StaticOrder, false>(ldsg, g, S, E, nullptr);
    }
    xcd_barrier(xb);
    {
        LOADP(p);
        pg8::Gemm g{p.cmpA, p.w1T, CMPA_ROWS, 512, 1024};
        CmpOrder S{nblk, bid};
        EpiZ E{p.Z};
        pg8::gemm_phase<EpiZ, CmpOrder, false>(ldsg, g, S, E, nullptr);
    }
    __syncthreads();
    { LOADP(p); phase_vn(p, bid, nblk); }
    xcd_barrier(xb);
    { LOADP(p); phase_cmp2(p, bid, nblk, ldsf); }
    { LOADP(p); phase_spatial(p, bid, nblk, ldsf + 1024); }
    xcd_barrier(xb);
    { LOADP(p); attn_units<false>(p, bid, nblk, ldsf); }
    { LOADP(p); attn_units<true>(p, bid, nblk, ldsf); }
    xcd_barrier(xb);
    {
        LOADP(p);
        pg8::Gemm g{p.a1bf, p.wpaT, MP, 1024, 512};
        pg8::StaticOrder S; S.init(MP, 1024, nblk, bid);
        EpiMerge1 E{p.projbf, p.out};
        pg8::gemm_phase<EpiMerge1, pg8::StaticOrder, false>(ldsg, g, S, E, nullptr);
    }
    __syncthreads();
    { LOADP(p); phase_merge_sample(p, bid, nblk, ldsf, 0); }
    xcd_barrier(xb);
    {
        LOADP(p);
        pg8::Gemm g{p.a2bf, p.wpbT, MP, 1024, 512};
        pg8::StaticOrder S; S.init(MP, 1024, nblk, bid);
        EpiMerge2 E{p.projbf, p.out, p.hbf};
        pg8::gemm_phase<EpiMerge2, pg8::StaticOrder, false>(ldsg, g, S, E, nullptr);
    }
    __syncthreads();
    { LOADP(p); phase_merge_sample(p, bid, nblk, ldsf, 1); }
    xcd_barrier(xb);
    {
        LOADP(p);
        pg8::Gemm g{p.hbf, p.woT, MP, 1024, 1024};
        pg8::StaticOrder S; S.init(MP, 1024, nblk, bid);
        EpiWo E{p.x_prompt, p.out};
        pg8::gemm_phase<EpiWo, pg8::StaticOrder, false>(ldsg, g, S, E, nullptr);
    }
    __syncthreads();
    { LOADP(p); phase_wo_sample(p, bid, nblk, ldsf); }
    xcd_barrier(xb);
    { LOADP(p); phase_final(p, bid, nblk); }
}

extern "C" void kernel_launch(void* const* d_in, const int* in_sizes, int n_in, void* d_out, int out_size, void* d_ws, size_t ws_size, hipStream_t stream) {
    Params p{};
    p.x_prompt = (const float*)d_in[0]; p.x_sample = (const float*)d_in[1];
    p.ck_cmp = (const float*)d_in[2]; p.cv_cmp = (const float*)d_in[3]; p.ck_sel = (const float*)d_in[4]; p.cv_sel = (const float*)d_in[5];
    p.ck_win = (const float*)d_in[6]; p.cv_win = (const float*)d_in[7]; p.page_table = (const int*)d_in[8];
    p.norm_g = (const float*)d_in[9]; p.w_in = (const float*)d_in[10];
    p.ck_w1 = (const float*)d_in[11]; p.ck_b1 = (const float*)d_in[12]; p.ck_w2 = (const float*)d_in[13]; p.ck_b2 = (const float*)d_in[14];
    p.cv_w1 = (const float*)d_in[15]; p.cv_b1 = (const float*)d_in[16]; p.cv_w2 = (const float*)d_in[17]; p.cv_b2 = (const float*)d_in[18];
    p.v_norm_g = (const float*)d_in[19]; p.v_norm_b = (const float*)d_in[20]; p.w_spatial = (const float*)d_in[21]; p.b_spatial = (const float*)d_in[22];
    p.w_pa = (const float*)d_in[23]; p.w_pb = (const float*)d_in[24]; p.w_o = (const float*)d_in[25]; p.final_g = (const float*)d_in[26];
    p.out = (float*)d_out;
    unsigned char* ws = (unsigned char*)d_ws; size_t off = 0;
    auto take = [&](size_t bytes) { unsigned char* q = ws + off; off += (bytes + 255) & ~(size_t)255; return q; };
    p.bar = (unsigned*)take(XCD_BAR_WORDS * 4);
    p.rope = (float*)take((size_t)ROPE_NPOS * 16 * 4);
    p.hbf = (bf16_t*)take((size_t)MPAD * 1024 * 2);
    p.winT = (bf16_t*)take((size_t)LDP * 1024 * 2);
    p.wpaT = (bf16_t*)take((size_t)1024 * 512 * 2);
    p.wpbT = (bf16_t*)take((size_t)1024 * 512 * 2);
    p.woT = (bf16_t*)take((size_t)1024 * 1024 * 2);
    p.w1T = (bf16_t*)take((size_t)512 * 1024 * 2);
    p.projbf = (bf16_t*)take((size_t)MPAD * LDP * 2);
    p.cmpA = (bf16_t*)take((size_t)CMPA_ROWS * 1024 * 2);
    p.Z = (float*)take((size_t)(CMPA_ROWS + 1) * 256 * 4);
    p.kc_p = (float*)take((size_t)2040 * 64 * 4); p.vc_p = (float*)take((size_t)2040 * 64 * 4);
    p.kc_s = (float*)take((size_t)32704 * 64 * 4); p.vc_s = (float*)take((size_t)32704 * 64 * 4);
    p.vn = (float*)take((size_t)MT * 512 * 4);
    p.a1bf = (bf16_t*)take((size_t)MPAD * 512 * 2);
    p.a2bf = (bf16_t*)take((size_t)MPAD * 512 * 2);
    p.msamp = (float*)take((size_t)MS * 1024 * 4);
    if (off > ws_size) { fprintf(stderr, "workspace too small: need %zu have %zu\n", off, ws_size); return; }
    static int grid_blocks = 0;
    if (!grid_blocks) {
        int dev = 0, cus = 0, per_cu = 0;
        hipGetDevice(&dev);
        hipDeviceGetAttribute(&cus, hipDeviceAttributeMultiprocessorCount, dev);
        hipFuncSetAttribute((const void*)k_mega, hipFuncAttributeMaxDynamicSharedMemorySize, LDS_BYTES);
        hipOccupancyMaxActiveBlocksPerMultiprocessor(&per_cu, k_mega, 512, LDS_BYTES);
        if (per_cu < 1) fprintf(stderr, "occupancy query reports %d blocks per CU\n", per_cu);
        grid_blocks = cus;
        if (grid_blocks > 256) grid_blocks = 256;
    }
    hipMemsetAsync(p.bar, 0, XCD_BAR_WORDS * 4, stream);
    void* args[] = {&p};
    hipError_t e = hipLaunchCooperativeKernel((void*)k_mega, dim3(grid_blocks), dim3(512), args, LDS_BYTES, stream);
    if (e != hipSuccess) fprintf(stderr, "cooperative launch failed: %s (grid %d)\n", hipGetErrorString(e), grid_blocks);
}
```

```cpp
#include <hip/hip_runtime.h>
#include <hip/hip_cooperative_groups.h>
#include <cstdint>
#include <cstdio>
namespace cg = cooperative_groups;
__device__ __forceinline__ int tid_opaque() { int t = threadIdx.x; asm volatile("" : "+v"(t)); return t; }

constexpr int BATCH = 4, SEQ = 4096, DEC_BATCH = 32, PAST_LEN = 8192;
constexpr int IN_WIDTH = 5400;
constexpr int MP = BATCH * SEQ;
constexpr int MS = DEC_BATCH * 4;
constexpr int MT = MP + MS;
constexpr int MPAD = 16640;
constexpr int LDP = 5632;
constexpr int N_PAGES = 64;
constexpr int NCMP_P = 255, NCMP_S = 511;
constexpr int NSEL_P = 64, NSEL_S = 129;
constexpr int C_Q = 0, C_KC = 512, C_VC = 640, C_KS = 768, C_VS = 896, C_KW = 1024, C_VW = 1152, C_GL = 1280,
              C_ZA = 1304, C_U = 1816, C_V = 2328, C_ZB = 2840, C_RA = 3352, C_RB = 4376;
constexpr size_t O_YP = 0;
constexpr size_t O_YS = O_YP + (size_t)MP * 1024;
constexpr size_t O_PKC = O_YS + (size_t)MS * 1024;
constexpr size_t O_PVC = O_PKC + (size_t)MP * 128;
constexpr size_t O_PKS = O_PVC + (size_t)MP * 128;
constexpr size_t O_PVS = O_PKS + (size_t)MP * 128;
constexpr size_t O_PKW = O_PVS + (size_t)MP * 128;
constexpr size_t O_PVW = O_PKW + (size_t)BATCH * 512 * 128;
constexpr size_t O_SKC = O_PVW + (size_t)BATCH * 512 * 128;
constexpr size_t O_SVC = O_SKC + (size_t)MS * 128;
constexpr size_t O_SKS = O_SVC + (size_t)MS * 128;
constexpr size_t O_SVS = O_SKS + (size_t)MS * 128;
constexpr size_t O_SKW = O_SVS + (size_t)MS * 128;
constexpr size_t O_SVW = O_SKW + (size_t)DEC_BATCH * 512 * 128;
constexpr size_t O_SVCH = O_SVW + (size_t)DEC_BATCH * 512 * 128;
constexpr size_t O_TOTAL = O_SVCH + (size_t)MS * 512;
static_assert(O_TOTAL == 30146560, "output size");
constexpr int ROPE_NPOS = 8200;
constexpr int CMPA_ROWS = 69632;
constexpr int LDS_BYTES = 131072 + 256;

namespace pg8 {
#define PG8_LAS __attribute__((address_space(3)))
typedef unsigned short bf16_t;
typedef short bf16x8 __attribute__((ext_vector_type(8)));
typedef float f32x4 __attribute__((ext_vector_type(4)));
typedef unsigned u32x4 __attribute__((ext_vector_type(4)));
constexpr int BM = 256, BK = 64, HALF = 128, HTB = HALF * BK * 2  , STAGE_BYTES = 8 * HTB, NXCD = 8, WGM = 8;

__host__ __device__ __forceinline__ int lds_byte(int r, int c) { const int st = (r >> 4) * 2 + (c >> 5), rr = r & 15, cc = c & 31, ob = rr * 64 + cc * 2; return st * 1024 + (ob ^ (((ob >> 9) & 1) << 5)); }
__host__ __device__ __forceinline__ void stage_rc(int b, int& R, int& C) { const int st = b / 1024, sb = b % 1024, swz = sb ^ (((sb >> 9) & 1) << 5); R = (st >> 1) * 16 + swz / 64; C = (st & 1) * 32 + (swz % 64) / 2; }
__host__ __device__ __forceinline__ int perm32(int rho) { const int n = rho >> 4, i = rho & 15; return 8 * (i >> 2) + 4 * n + (i & 3); }

struct Unit { int pm, pn; };
struct Gemm { const bf16_t* A; const bf16_t* Bt; int M, N, K; };

struct StaticOrder {
    int nM, nN, nwg, G, c;
    __host__ __device__ __forceinline__ void init(int M, int N, int G_, int c_) { nM = M / BM; nN = N / BM; nwg = nM * nN; G = G_; c = c_; }
    __host__ __device__ bool next(int i, Unit& u) const {
        const long L = (long)i * G + c; if (L >= nwg) return false;
        int wgid = (int)L; { const int q = nwg / NXCD, r = nwg % NXCD, xcd = wgid % NXCD, off = wgid / NXCD; wgid = (xcd < r ? xcd * (q + 1) : r * (q + 1) + (xcd - r) * q) + off; }
        const int nig = WGM * nN, gid = wgid / nig, fm = gid * WGM, gsz = (nM - fm) < WGM ? (nM - fm) : WGM;
        u.pm = fm + ((wgid % nig) % gsz); u.pn = (wgid % nig) / gsz; return true;
    }
    __device__ __forceinline__ void a_ready(const Unit&) const {}
    __device__ __forceinline__ void done(const Unit&) const {}
};
__device__ __forceinline__ unsigned cvt_pk_bf16(float lo, float hi) { unsigned r; asm volatile("v_cvt_pk_bf16_f32 %0, %1, %2" : "=v"(r) : "v"(lo), "v"(hi)); return r; }
template <class Epi, class Sched, bool STAMP = false>
__device__ __forceinline__ void gemm_phase(PG8_LAS unsigned char* lds, const Gemm g, const Sched& S, const Epi& E, unsigned long long* stamps) {
    const int tid = tid_opaque(), wid = __builtin_amdgcn_readfirstlane(tid >> 6), lane = tid & 63, wr = wid >> 2, wc = wid & 3, fr = lane & 15, fq = lane >> 4;
    const int K = g.K, nt = K / BK;
    int ts_lo = 0, ts_hi = 0, nts = 0; const unsigned long long rt_entry = STAMP ? (unsigned long long)wall_clock64() : 0ull;
#define PG8_STAMP() do { if (STAMP && wid == 0 && nts < 64) { const unsigned long long _c = (unsigned long long)clock64(); \
        ts_lo = (lane == nts) ? (int)(unsigned)_c : ts_lo; ts_hi = (lane == nts) ? (int)(unsigned)(_c >> 32) : ts_hi; ++nts; } } while (0)
    PG8_STAMP();
    unsigned voffA[2], voffB[2];
#pragma unroll
    for (int i = 0; i < 2; ++i) { int R, C; stage_rc(tid * 16 + i * 8192, R, C); const int Rb = Epi::PERM ? ((R & ~31) + perm32(R & 31)) : R;
        voffA[i] = (unsigned)(R * K + C) * 2u; voffB[i] = (unsigned)(Rb * K + C) * 2u; }
    const size_t kstep = (size_t)(BK * 2);
    const size_t hstep = (size_t)HALF * K * 2;
    const size_t tstep = 2 * hstep;
    const unsigned ldsw = (unsigned)wid * 1024u;
    const int aoff = lds_byte(wr * 64 + fr, fq * 8), boff = lds_byte(wc * 32 + fr, fq * 8);
#define PG8_SA(b, h) (((b) * 2 + (h)) * HTB)
#define PG8_SB(b, h) ((4 + (b) * 2 + (h)) * HTB)
#define PG8_STAGE(bufoff, gbase, voff) do { _Pragma("unroll") for (int _i = 0; _i < 2; ++_i) \
        __builtin_amdgcn_global_load_lds((const unsigned*)((const char*)(gbase) + (voff)[_i]), (PG8_LAS unsigned*)(lds + (bufoff) + ldsw + _i * 8192), 16, 0, 0); } while (0)
#define PG8_LDA(dst, b, h) do { _Pragma("unroll") for (int m = 0; m < 4; ++m) _Pragma("unroll") for (int k = 0; k < 2; ++k) dst[m][k] = *(const PG8_LAS bf16x8*)(lds + PG8_SA(b, h) + aoff + m * 2048 + k * 1024); } while (0)
#define PG8_LDB(dst, b, h) do { _Pragma("unroll") for (int n = 0; n < 2; ++n) _Pragma("unroll") for (int k = 0; k < 2; ++k) dst[n][k] = *(const PG8_LAS bf16x8*)(lds + PG8_SB(b, h) + boff + n * 2048 + k * 1024); } while (0)
#define PG8_MMA(ai, bj, At, Bt) do { __builtin_amdgcn_s_setprio(1); _Pragma("unroll") for (int m = 0; m < 4; ++m) _Pragma("unroll") for (int n = 0; n < 2; ++n) _Pragma("unroll") for (int k = 0; k < 2; ++k) \
        acc[ai][bj][m][n] = __builtin_amdgcn_mfma_f32_16x16x32_bf16(Bt[n][k], At[m][k], acc[ai][bj][m][n], 0, 0, 0); __builtin_amdgcn_s_setprio(0); } while (0)
#define PG8_WAIT_V(n) asm volatile("s_waitcnt vmcnt(" #n ")" ::: "memory")
#define PG8_WAIT_L(n) asm volatile("s_waitcnt lgkmcnt(" #n ")" ::: "memory")
#define PG8_BAR __builtin_amdgcn_s_barrier()
#define PG8_SCHED __builtin_amdgcn_sched_barrier(0)
    Unit cur, nxt; int ui = 0;
    if (!S.next(0, cur)) return;
    f32x4 acc[2][2][4][2];
#pragma unroll
    for (int a = 0; a < 2; ++a)
#pragma unroll
        for (int b = 0; b < 2; ++b)
#pragma unroll
            for (int m = 0; m < 4; ++m)
#pragma unroll
                for (int n = 0; n < 2; ++n) acc[a][b][m][n] = (f32x4){0.f, 0.f, 0.f, 0.f};
    bf16x8 At[4][2], B0[2][2], B1[2][2];
    const char* cA = (const char*)g.A + (size_t)cur.pm * tstep; const char* cB = (const char*)g.Bt + (size_t)cur.pn * tstep;
    S.a_ready(cur);
    PG8_STAGE(PG8_SB(0, 0), cB, voffB); PG8_STAGE(PG8_SA(0, 0), cA, voffA); PG8_STAGE(PG8_SB(0, 1), cB + hstep, voffB); PG8_STAGE(PG8_SA(0, 1), cA + hstep, voffA);
    if (wr == 1) PG8_BAR;
    PG8_WAIT_V(4); PG8_BAR;
    PG8_STAGE(PG8_SB(1, 0), cB + kstep, voffB); PG8_STAGE(PG8_SA(1, 0), cA + kstep, voffA); PG8_STAGE(PG8_SB(1, 1), cB + hstep + kstep, voffB);
    PG8_WAIT_V(6); PG8_BAR;
    PG8_STAMP();
    for (;;) {
        const bool has_next = S.next(ui + 1, nxt);
        const char* nA = has_next ? (const char*)g.A + (size_t)nxt.pm * tstep : cA; const char* nB = has_next ? (const char*)g.Bt + (size_t)nxt.pn * tstep : cB;
        for (int t = 0; t < nt; t += 2) {
            const bool last = (t == nt - 2);
            const char* a1 = cA + (size_t)(t + 1) * kstep;
            const char* a2 = last ? nA : cA + (size_t)(t + 2) * kstep; const char* b2 = last ? nB : cB + (size_t)(t + 2) * kstep;
            const char* a3 = a2 + kstep; const char* b3 = b2 + kstep;
            if (last && has_next) S.a_ready(nxt);
            PG8_LDB(B0, 0, 0); PG8_SCHED; PG8_LDA(At, 0, 0); PG8_STAGE(PG8_SA(1, 1), a1 + hstep, voffA);
            PG8_WAIT_L(8); PG8_BAR; PG8_WAIT_L(0); PG8_MMA(0, 0, At, B0); PG8_BAR; PG8_SCHED;
            PG8_LDB(B1, 0, 1); PG8_STAGE(PG8_SB(0, 0), b2, voffB);
            PG8_BAR; PG8_WAIT_L(0); PG8_MMA(0, 1, At, B1); PG8_BAR;
            PG8_LDA(At, 0, 1); PG8_STAGE(PG8_SA(0, 0), a2, voffA);
            PG8_BAR; PG8_WAIT_L(0); PG8_MMA(1, 0, At, B0); PG8_BAR; PG8_SCHED;
            PG8_STAGE(PG8_SB(0, 1), b2 + hstep, voffB);
            PG8_WAIT_V(6); PG8_BAR; PG8_MMA(1, 1, At, B1); PG8_BAR;
            PG8_LDB(B0, 1, 0); PG8_SCHED; PG8_LDA(At, 1, 0); PG8_STAGE(PG8_SA(0, 1), a2 + hstep, voffA);
            PG8_WAIT_L(8); PG8_BAR; PG8_WAIT_L(0); PG8_MMA(0, 0, At, B0); PG8_BAR; PG8_SCHED;
            PG8_LDB(B1, 1, 1); PG8_STAGE(PG8_SB(1, 0), b3, voffB);
            PG8_BAR; PG8_WAIT_L(0); PG8_MMA(0, 1, At, B1); PG8_BAR;
            PG8_LDA(At, 1, 1); PG8_STAGE(PG8_SA(1, 0), a3, voffA);
            PG8_BAR; PG8_WAIT_L(0); PG8_MMA(1, 0, At, B0); PG8_BAR; PG8_SCHED;
            PG8_STAGE(PG8_SB(1, 1), b3 + hstep, voffB);
            PG8_WAIT_V(6); PG8_BAR; PG8_MMA(1, 1, At, B1); PG8_BAR;
        }
        PG8_STAMP();
        if constexpr (!Epi::AFTER_DRAIN) { E(acc, cur, wr, wc, fr, fq); S.done(cur); }
        PG8_STAMP();
        if (!has_next) break;
#pragma unroll
        for (int a = 0; a < 2; ++a)
#pragma unroll
            for (int b = 0; b < 2; ++b)
#pragma unroll
                for (int m = 0; m < 4; ++m)
#pragma unroll
                    for (int n = 0; n < 2; ++n) acc[a][b][m][n] = (f32x4){0.f, 0.f, 0.f, 0.f};
        cur = nxt; cA = nA; cB = nB; ++ui;
    }
    PG8_WAIT_V(0);
    if (wr == 0) PG8_BAR;
    PG8_BAR;
    if constexpr (Epi::AFTER_DRAIN) { E.fused(acc, cur, wr, wc, fr, fq, lds, wid, lane); S.done(cur); }
    PG8_STAMP();
    if (STAMP && wid == 0) { stamps[lane] = lane < nts ? (((unsigned long long)(unsigned)ts_hi << 32) | (unsigned)ts_lo) : 0ull;
        if (lane == 62) stamps[62] = rt_entry; if (lane == 63) stamps[63] = (unsigned long long)wall_clock64(); }
#undef PG8_STAMP
#undef PG8_SA
#undef PG8_SB
#undef PG8_STAGE
#undef PG8_LDA
#undef PG8_LDB
#undef PG8_MMA
#undef PG8_WAIT_V
#undef PG8_WAIT_L
#undef PG8_BAR
#undef PG8_SCHED
}
}
#define USE_CG_SYNC 1
#define DBG_ATTN 0

#define XB_TMO      128
#define XB_XCNT(j)  (256  + 64 * (j))
#define XB_XSUB(j)  (1280 + 64 * (j))
#define XB_XGEN(j)  (2304 + 64 * (j))
#define XB_TOP      3328
#define XB_TOPGEN   3392
#define XCD_BAR_WORDS 3456
#define XB_SPIN_CAP (1u << 18)
#define LAS __attribute__((address_space(3)))
__device__ __forceinline__ unsigned xb_ld(unsigned* p)              { return __hip_atomic_load(p, __ATOMIC_RELAXED, __HIP_MEMORY_SCOPE_AGENT); }
__device__ __forceinline__ unsigned xb_add(unsigned* p, unsigned v) { return __hip_atomic_fetch_add(p, v, __ATOMIC_RELAXED, __HIP_MEMORY_SCOPE_AGENT); }
__device__ __forceinline__ unsigned xb_xcc_id() { return (unsigned)__builtin_amdgcn_s_getreg((3 << 11) | 20) & 0xFu; }
#define XB_SPIN(cond, bar) do { unsigned _sp = 0; while (cond) { __builtin_amdgcn_s_sleep(1); \
    if ((++_sp & 255u) == 0u) { if (xb_ld(&(bar)[XB_TMO])) break; if (_sp > XB_SPIN_CAP) { atomicAdd(&(bar)[XB_TMO], 1u); break; } } } } while (0)
struct XcdBarrier { unsigned* bar; unsigned x; volatile LAS unsigned* st; };
__device__ __forceinline__ XcdBarrier xcd_barrier_post(unsigned* bar, volatile LAS unsigned* st) {
    XcdBarrier b; b.bar = bar; b.x = xb_xcc_id(); b.st = st;
    if (threadIdx.x == 0) (void)xb_add(&bar[XB_XCNT(b.x)], 1u);
    return b;
}
__device__ __forceinline__ void xcd_barrier_complete(unsigned* bar, unsigned x, unsigned& nloc, unsigned& nx) {
    const unsigned G = gridDim.x * gridDim.y * gridDim.z;
    unsigned sum, cnt, mine, sp = 0u;
    for (;;) {
        sum = 0u; cnt = 0u; mine = 0u;
#pragma unroll
        for (unsigned j = 0; j < 16; ++j) { const unsigned c = xb_ld(&bar[XB_XCNT(j)]); sum += c; cnt += (c > 0u) ? 1u : 0u; mine = (j == x) ? c : mine; }
        if (sum == G) break;
        __builtin_amdgcn_s_sleep(1);
        if ((++sp & 255u) == 0u) { if (xb_ld(&bar[XB_TMO])) break; if (sp > XB_SPIN_CAP) { atomicAdd(&bar[XB_TMO], 1u); break; } }
    }
    nloc = mine > 0u ? mine : 1u; nx = cnt > 0u ? cnt : 1u;
}
__device__ __forceinline__ void xcd_barrier(const XcdBarrier& b) {
    asm volatile("s_waitcnt vmcnt(0)" ::: "memory");
    __syncthreads();
    if (threadIdx.x == 0) {
        unsigned* bar = b.bar;
        __builtin_amdgcn_s_waitcnt(0);
        unsigned nloc = b.st[0], nx = b.st[1];
        if (nloc == 0u) { xcd_barrier_complete(bar, b.x, nloc, nx); b.st[0] = nloc; b.st[1] = nx; }
        const unsigned old = xb_add(&bar[XB_XSUB(b.x)], 1u);
        const unsigned gen = old / nloc;
        if (old + 1u == (gen + 1u) * nloc) {
            __builtin_amdgcn_fence(__ATOMIC_RELEASE, "agent");
            asm volatile("s_waitcnt vmcnt(0)" ::: "memory");
            const unsigned og = xb_add(&bar[XB_TOP], 1u);
            const unsigned tg = og / nx;
            if (og + 1u == (tg + 1u) * nx) xb_add(&bar[XB_TOPGEN], 1u);
            else XB_SPIN(xb_ld(&bar[XB_TOPGEN]) == tg, bar);
            __builtin_amdgcn_fence(__ATOMIC_ACQUIRE, "agent");
            xb_add(&bar[XB_XGEN(b.x)], 1u);
            asm volatile("s_waitcnt vmcnt(0)" ::: "memory");
        } else {
            XB_SPIN(xb_ld(&bar[XB_XGEN(b.x)]) == gen, bar);
            __builtin_amdgcn_fence(__ATOMIC_ACQUIRE, "agent");
            asm volatile("s_waitcnt vmcnt(0)" ::: "memory");
        }
    }
    __syncthreads();
}

typedef unsigned short bf16_t;
typedef float f32x4 __attribute__((ext_vector_type(4)));
typedef unsigned u32x4 __attribute__((ext_vector_type(4)));
using pg8::cvt_pk_bf16;

struct Params {
    const float* x_prompt; const float* x_sample;
    const float* ck_cmp; const float* cv_cmp; const float* ck_sel; const float* cv_sel; const float* ck_win; const float* cv_win;
    const int* page_table;
    const float* norm_g; const float* w_in;
    const float* ck_w1; const float* ck_b1; const float* ck_w2; const float* ck_b2;
    const float* cv_w1; const float* cv_b1; const float* cv_w2; const float* cv_b2;
    const float* v_norm_g; const float* v_norm_b; const float* w_spatial; const float* b_spatial;
    const float* w_pa; const float* w_pb; const float* w_o; const float* final_g;
    float* out;
    unsigned* bar;
    float* rope;
    bf16_t* hbf;
    bf16_t* winT;
    bf16_t* wpaT;
    bf16_t* wpbT;
    bf16_t* woT;
    bf16_t* w1T;
    bf16_t* projbf;
    bf16_t* cmpA;
    float* Z;
    float* kc_p; float* vc_p; float* kc_s; float* vc_s;
    float* vn;
    bf16_t* a1bf;
    bf16_t* a2bf;
    float* msamp;
    bf16_t* kcbf; bf16_t* vcbf;
    float* dbg_acc; unsigned long long* dbg_masks; unsigned long long* dbg_masks_ref; bf16_t* a1ref;
};

__device__ __forceinline__ float bf2f(unsigned short b) { return __uint_as_float(((unsigned)b) << 16); }
__device__ __forceinline__ float bflo(unsigned w) { return __uint_as_float(w << 16); }
__device__ __forceinline__ float bfhi(unsigned w) { return __uint_as_float(w & 0xffff0000u); }
__device__ __forceinline__ bf16_t f2bf(float f) { unsigned u = __float_as_uint(f); u += 0x7FFFu + ((u >> 16) & 1u); return (bf16_t)(u >> 16); }
__device__ __forceinline__ float gelu_tanh(float x) {
    const float c = 0.7978845608028654f;
    const float u = c * (x + 0.044715f * x * x * x);
    return 0.5f * x * (1.0f + tanhf(u));
}
__device__ __forceinline__ float sigmoidf_(float x) { return 1.0f / (1.0f + expf(-x)); }
__device__ __forceinline__ float siluf_(float x) { return x * sigmoidf_(x); }
__device__ __forceinline__ float wave_sum(float v) {
#pragma unroll
    for (int o = 32; o > 0; o >>= 1) v += __shfl_xor(v, o);
    return v;
}
__device__ __forceinline__ float wave_max(float v) {
#pragma unroll
    for (int o = 32; o > 0; o >>= 1) v = fmaxf(v, __shfl_xor(v, o));
    return v;
}
__device__ __forceinline__ const float* xrow(const Params& p, int r) {
    return r < MP ? p.x_prompt + (size_t)r * 1024 : p.x_sample + (size_t)(r - MP) * 1024;
}
__device__ __forceinline__ int row_pos(int r) { return r < MP ? (r & (SEQ - 1)) : PAST_LEN + ((r - MP) & 3); }

template <class AL, class BL, class EP>
__device__ __forceinline__ void sgemm_tiles(int M, int N, int K, const AL& al, const BL& bl, const EP& ep, int bid, int nblk, float* lds) {
    const int tid0_ = tid_opaque(); const int half = tid0_ >> 8, tid = tid0_ & 255, tx = tid & 15, ty = tid >> 4;
    const int tm = (M + 63) / 64, tn = (N + 63) / 64, nt = tm * tn;
    float (*As)[68] = (float (*)[68])(lds + half * 2176);
    float (*Bs)[68] = (float (*)[68])(lds + half * 2176 + 16 * 68);
    for (int tile0 = bid * 2; tile0 < nt; tile0 += nblk * 2) {
        const int tile = tile0 + half;
        const bool valid = tile < nt;
        const int m0 = (tile / tn) * 64, n0 = (tile % tn) * 64;
        float acc[4][4];
#pragma unroll
        for (int i = 0; i < 4; ++i)
#pragma unroll
            for (int j = 0; j < 4; ++j) acc[i][j] = 0.f;
        for (int k0 = 0; k0 < K; k0 += 16) {
            {
                const int r = tid >> 2, kq = (tid & 3) * 4;
                float4 v = make_float4(0.f, 0.f, 0.f, 0.f);
                if (valid && m0 + r < M) v = al(m0 + r, k0 + kq, n0);
                As[kq + 0][r] = v.x; As[kq + 1][r] = v.y; As[kq + 2][r] = v.z; As[kq + 3][r] = v.w;
            }
            {
                const int kk = tid >> 4, c = (tid & 15) * 4;
                float4 v = make_float4(0.f, 0.f, 0.f, 0.f);
                if (valid && n0 + c < N) v = bl(k0 + kk, n0 + c, m0);
                *(float4*)&Bs[kk][c] = v;
            }
            __syncthreads();
#pragma unroll
            for (int kk = 0; kk < 16; ++kk) {
                const float4 a = *(const float4*)&As[kk][ty * 4];
                const float4 b = *(const float4*)&Bs[kk][tx * 4];
                acc[0][0] += a.x * b.x; acc[0][1] += a.x * b.y; acc[0][2] += a.x * b.z; acc[0][3] += a.x * b.w;
                acc[1][0] += a.y * b.x; acc[1][1] += a.y * b.y; acc[1][2] += a.y * b.z; acc[1][3] += a.y * b.w;
                acc[2][0] += a.z * b.x; acc[2][1] += a.z * b.y; acc[2][2] += a.z * b.z; acc[2][3] += a.z * b.w;
                acc[3][0] += a.w * b.x; acc[3][1] += a.w * b.y; acc[3][2] += a.w * b.z; acc[3][3] += a.w * b.w;
            }
            __syncthreads();
        }
        if (valid) {
#pragma unroll
            for (int i = 0; i < 4; ++i) {
                const int row = m0 + ty * 4 + i, col = n0 + tx * 4;
                if (row < M && col < N) ep(row, col, make_float4(acc[i][0], acc[i][1], acc[i][2], acc[i][3]));
            }
        }
    }
}
__device__ __forceinline__ float4 ld_bf4(const bf16_t* p) {
    const uint2 w = *(const uint2*)p;
    return make_float4(bflo(w.x), bfhi(w.x), bflo(w.y), bfhi(w.y));
}

__device__ __forceinline__ void transpose_to_bf16(const float* src, int lsrc, int K, int N, int Npad, bf16_t* dst, int ldd, int bid, int nblk, float* lds) {
    const int tid = tid_opaque();
    const int tk = K / 64, tn = Npad / 64;
    float (*T)[65] = (float (*)[65])lds;
    for (int tile = bid; tile < tk * tn; tile += nblk) {
        const int k0 = (tile % tk) * 64, n0 = (tile / tk) * 64;
#pragma unroll
        for (int i = 0; i < 2; ++i) {
            const int kk = (tid >> 4) + i * 32, c = (tid & 15) * 4;
            float4 v = make_float4(0.f, 0.f, 0.f, 0.f);
            if (n0 + c < N) v = *(const float4*)(src + (size_t)(k0 + kk) * lsrc + n0 + c);
            T[kk][c + 0] = v.x; T[kk][c + 1] = v.y; T[kk][c + 2] = v.z; T[kk][c + 3] = v.w;
        }
        __syncthreads();
        {
            const int n = tid >> 3, kq = (tid & 7) * 8;
            u32x4 w;
            w.x = cvt_pk_bf16(T[kq + 0][n], T[kq + 1][n]); w.y = cvt_pk_bf16(T[kq + 2][n], T[kq + 3][n]);
            w.z = cvt_pk_bf16(T[kq + 4][n], T[kq + 5][n]); w.w = cvt_pk_bf16(T[kq + 6][n], T[kq + 7][n]);
            *(u32x4*)(dst + (size_t)(n0 + n) * ldd + k0 + kq) = w;
        }
        __syncthreads();
    }
}

__device__ __forceinline__ void phase_prep(const Params& p, int bid, int nblk, float* lds) {
    const int tid = tid_opaque(), lane = tid & 63, wid = tid >> 6;
    for (int i = bid * 512 + tid; i < ROPE_NPOS * 8; i += nblk * 512) {
        const int pos = i >> 3, f = i & 7;
        const double inv[8] = {1.0, 0.19392274474868576, 0.03760603093086393, 0.007292664737217109,
                               0.001414213562373095, 0.0002742481756762073, 5.318295896944988e-05, 1.031338537721246e-05};
        double invf = inv[0];
#pragma unroll
        for (int j = 1; j < 8; ++j) invf = (f == j) ? inv[j] : invf;
        const double a = (double)pos * invf * 0.15915494309189535;
        const float rf = (float)((a - rint(a)) * 6.283185307179586);
        p.rope[i * 2 + 0] = cosf(rf);
        p.rope[i * 2 + 1] = sinf(rf);
    }
    for (int r = bid * 8 + wid; r < MPAD; r += nblk * 8) {
        bf16_t* dst = p.hbf + (size_t)r * 1024;
        if (r >= MT) {
#pragma unroll
            for (int i = 0; i < 2; ++i) *(u32x4*)(dst + (i * 64 + lane) * 8) = (u32x4){0u, 0u, 0u, 0u};
            continue;
        }
        const float* x = xrow(p, r);
        float4 v[4]; float ss = 0.f;
#pragma unroll
        for (int i = 0; i < 4; ++i) {
            v[i] = *(const float4*)(x + (i * 64 + lane) * 4);
            ss += v[i].x * v[i].x + v[i].y * v[i].y + v[i].z * v[i].z + v[i].w * v[i].w;
        }
        ss = wave_sum(ss);
        const float rs = rsqrtf(ss * (1.0f / 1024.0f) + 1e-6f);
#pragma unroll
        for (int i = 0; i < 4; ++i) {
            const float4 g = *(const float4*)(p.norm_g + (i * 64 + lane) * 4);
            uint2 w;
            w.x = cvt_pk_bf16(v[i].x * rs * g.x, v[i].y * rs * g.y); w.y = cvt_pk_bf16(v[i].z * rs * g.z, v[i].w * rs * g.w);
            *(uint2*)(dst + (i * 64 + lane) * 4) = w;
        }
    }
    transpose_to_bf16(p.w_in, IN_WIDTH, 1024, IN_WIDTH, LDP, p.winT, 1024, bid, nblk, lds);
    transpose_to_bf16(p.w_pa, 1024, 512, 1024, 1024, p.wpaT, 512, bid, nblk, lds);
    transpose_to_bf16(p.w_pb, 1024, 512, 1024, 1024, p.wpbT, 512, bid, nblk, lds);
    transpose_to_bf16(p.w_o, 1024, 1024, 1024, 1024, p.woT, 1024, bid, nblk, lds);
    transpose_to_bf16(p.ck_w1, 128, 1024, 128, 128, p.w1T, 1024, bid, nblk, lds);
    transpose_to_bf16(p.ck_w1 + (size_t)1024 * 128, 128, 1024, 128, 128, p.w1T + (size_t)128 * 1024, 1024, bid, nblk, lds);
    transpose_to_bf16(p.cv_w1, 128, 1024, 128, 128, p.w1T + (size_t)256 * 1024, 1024, bid, nblk, lds);
    transpose_to_bf16(p.cv_w1 + (size_t)1024 * 128, 128, 1024, 128, 128, p.w1T + (size_t)384 * 1024, 1024, bid, nblk, lds);
    const int tot2 = DEC_BATCH * 508 * 32;
    for (int i = bid * 512 + tid; i < tot2; i += nblk * 512) {
        const int b = i / (508 * 32), rem = i % (508 * 32);
        const int j = rem >> 5, w = (rem & 31) * 4;
        *(float4*)(p.out + O_SKW + ((size_t)b * 512 + j) * 128 + w) = *(const float4*)(p.ck_win + ((size_t)b * 512 + j + 4) * 128 + w);
        *(float4*)(p.out + O_SVW + ((size_t)b * 512 + j) * 128 + w) = *(const float4*)(p.cv_win + ((size_t)b * 512 + j + 4) * 128 + w);
    }
    const int tot3 = 2 * DEC_BATCH * PAST_LEN * 16;
    for (int i = bid * 512 + tid; i < tot3; i += nblk * 512) {
        const int d8 = i & 7, g = (i >> 3) & 1, pos = (i >> 4) & (PAST_LEN - 1), b = (i >> 17) & 31, ten = i >> 22;
        const float* pool = ten ? p.cv_cmp : p.ck_cmp;
        const int phys = p.page_table[b * N_PAGES + (pos >> 7)];
        const float* s = pool + (((size_t)phys * 128 + (pos & 127)) * 2 + g) * 64 + d8 * 8;
        const float4 a = *(const float4*)s, c = *(const float4*)(s + 4);
        u32x4 w; w.x = cvt_pk_bf16(a.x, a.y); w.y = cvt_pk_bf16(a.z, a.w); w.z = cvt_pk_bf16(c.x, c.y); w.w = cvt_pk_bf16(c.z, c.w);
        *(u32x4*)(p.cmpA + ((size_t)ten * 32768 + (b * 2 + g) * 512 + (pos >> 4)) * 1024 + (pos & 15) * 64 + d8 * 8) = w;
    }
}

struct EpiProj {
    static constexpr bool PERM = true, AFTER_DRAIN = false;
    bf16_t* projbf; float* out; const float* rope; bf16_t* cmpA;
    __device__ __forceinline__ void operator()(const f32x4 (&acc)[2][2][4][2], const pg8::Unit& u, int wr, int wc, int fr, int fq) const {
        const int pn = u.pn;
#pragma unroll
        for (int ai = 0; ai < 2; ++ai)
#pragma unroll
            for (int m = 0; m < 4; ++m) {
                const int row = u.pm * 256 + ai * 128 + wr * 64 + m * 16 + fr;
                const int pos = row < MT ? row_pos(row) : 0;
#pragma unroll
                for (int bj = 0; bj < 2; ++bj) {
                    f32x4 v0 = acc[ai][bj][m][0], v1 = acc[ai][bj][m][1];
                    const int col0 = pn * 256 + bj * 128 + wc * 32 + 8 * fq;
                    const bool roped = (pn <= 1 || ((pn == 3 || pn == 4) && bj == 0)) && ((wc & 1) == 0);
                    if (roped) {
                        f32x4 q0, q1;
#pragma unroll
                        for (int i = 0; i < 4; ++i) { q0[i] = __shfl_xor(v0[i], 16); q1[i] = __shfl_xor(v1[i], 16); }
                        if (fq < 2) {
                            const float4* cs = (const float4*)(rope + (size_t)pos * 16);
                            const float4 c01 = cs[0], c23 = cs[1], c45 = cs[2], c67 = cs[3];
                            const float sg = fq == 0 ? -1.0f : 1.0f;
                            v0[0] = v0[0] * c01.x + sg * q0[0] * c01.y; v0[1] = v0[1] * c01.z + sg * q0[1] * c01.w;
                            v0[2] = v0[2] * c23.x + sg * q0[2] * c23.y; v0[3] = v0[3] * c23.z + sg * q0[3] * c23.w;
                            v1[0] = v1[0] * c45.x + sg * q1[0] * c45.y; v1[1] = v1[1] * c45.z + sg * q1[1] * c45.w;
                            v1[2] = v1[2] * c67.x + sg * q1[2] * c67.y; v1[3] = v1[3] * c67.z + sg * q1[3] * c67.w;
                        }
                    }
                    u32x4 w; w.x = cvt_pk_bf16(v0[0], v0[1]); w.y = cvt_pk_bf16(v0[2], v0[3]); w.z = cvt_pk_bf16(v1[0], v1[1]); w.w = cvt_pk_bf16(v1[2], v1[3]);
                    *(u32x4*)(projbf + (size_t)row * LDP + col0) = w;
                    if (pn >= 2 && pn <= 4 && row < MT) {
                        const int cc = col0 - 512, sec = cc >> 7, wv = cc & 127;
                        float* dst = nullptr;
                        if (row < MP) {
                            const int b = row >> 12, t = row & 4095;
                            if (sec < 4) dst = out + O_PKC + (size_t)sec * MP * 128 + (size_t)row * 128 + wv;
                            else if (t >= SEQ - 512) dst = out + (sec == 4 ? O_PKW : O_PVW) + ((size_t)b * 512 + (t - (SEQ - 512))) * 128 + wv;
                            if (sec < 2) {
                                const int g = wv >> 6, d = wv & 63;
                                *(u32x4*)(cmpA + ((size_t)(65536 + sec * 2048 + (b * 2 + g) * 256 + (t >> 4))) * 1024 + (t & 15) * 64 + d) = w;
                            }
                        } else {
                            const int rs = row - MP, b = rs >> 2, t = rs & 3;
                            if (sec < 4) dst = out + O_SKC + (size_t)sec * MS * 128 + (size_t)rs * 128 + wv;
                            else dst = out + (sec == 4 ? O_SKW : O_SVW) + ((size_t)b * 512 + 508 + t) * 128 + wv;
                        }
                        if (dst) { *(f32x4*)dst = v0; *(f32x4*)(dst + 4) = v1; }
                    }
                }
            }
    }
};

struct CmpOrder {
    int G, c;
    __device__ bool next(int i, pg8::Unit& u) const {
        const int L = i * G + c; if (L >= CMPA_ROWS / 256) return false;
        u.pm = L; u.pn = (L < 128) ? 0 : (L < 256) ? 1 : (L < 264) ? 0 : 1; return true;
    }
    __device__ __forceinline__ void a_ready(const pg8::Unit&) const {}
    __device__ __forceinline__ void done(const pg8::Unit&) const {}
};
struct EpiZ {
    static constexpr bool PERM = false, AFTER_DRAIN = false;
    float* Z;
    __device__ __forceinline__ void operator()(const f32x4 (&acc)[2][2][4][2], const pg8::Unit& u, int wr, int wc, int fr, int fq) const {
#pragma unroll
        for (int ai = 0; ai < 2; ++ai)
#pragma unroll
            for (int m = 0; m < 4; ++m) {
                float* rowp = Z + (size_t)(u.pm * 256 + ai * 128 + wr * 64 + m * 16 + fr) * 256 + wc * 32 + 4 * fq;
#pragma unroll
                for (int bj = 0; bj < 2; ++bj)
#pragma unroll
                    for (int n = 0; n < 2; ++n) *(f32x4*)(rowp + bj * 128 + n * 16) = acc[ai][bj][m][n];
            }
    }
};

__device__ __forceinline__ void phase_vn(const Params& p, int bid, int nblk) {
    const int tid = tid_opaque(), lane = tid & 63, wid = tid >> 6;
    for (int r = bid * 8 + wid; r < MT; r += nblk * 8) {
        const u32x4 w = *(const u32x4*)(p.projbf + (size_t)r * LDP + C_V + lane * 8);
        float ge[8];
        ge[0] = gelu_tanh(bflo(w.x)); ge[1] = gelu_tanh(bfhi(w.x)); ge[2] = gelu_tanh(bflo(w.y)); ge[3] = gelu_tanh(bfhi(w.y));
        ge[4] = gelu_tanh(bflo(w.z)); ge[5] = gelu_tanh(bfhi(w.z)); ge[6] = gelu_tanh(bflo(w.w)); ge[7] = gelu_tanh(bfhi(w.w));
        float s = 0.f;
#pragma unroll
        for (int i = 0; i < 8; ++i) s += ge[i];
        const float mu = wave_sum(s) * (1.0f / 512.0f);
        float q = 0.f;
#pragma unroll
        for (int i = 0; i < 8; ++i) { const float d = ge[i] - mu; q += d * d; }
        const float rstd = rsqrtf(wave_sum(q) * (1.0f / 512.0f) + 1e-6f);
        float y[8];
#pragma unroll
        for (int i = 0; i < 8; ++i) { const int c = lane * 8 + i; y[i] = (ge[i] - mu) * rstd * p.v_norm_g[c] + p.v_norm_b[c]; }
        float* dst = p.vn + (size_t)r * 512 + lane * 8;
        *(float4*)dst = make_float4(y[0], y[1], y[2], y[3]); *(float4*)(dst + 4) = make_float4(y[4], y[5], y[6], y[7]);
        if (r >= MP) {
            float* d2 = p.out + O_SVCH + (size_t)(r - MP) * 512 + lane * 8;
            *(float4*)d2 = make_float4(y[0], y[1], y[2], y[3]); *(float4*)(d2 + 4) = make_float4(y[4], y[5], y[6], y[7]);
        }
    }
}

template <bool ISV, bool SAMP>
__device__ __forceinline__ void phase_cmp2_v(const Params& p, int bid, int nblk, float* lds) {
    const int tid = tid_opaque(), lane = tid & 63, wid = tid >> 6;
    float* hidw = lds + wid * 128;
    constexpr int ncmp = SAMP ? NCMP_S : NCMP_P, nseg = SAMP ? 512 : 256;
    const int total = (SAMP ? DEC_BATCH : BATCH) * ncmp * 2;
    const float* b1 = ISV ? p.cv_b1 : p.ck_b1; const float* w2 = ISV ? p.cv_w2 : p.ck_w2; const float* b2 = ISV ? p.cv_b2 : p.ck_b2;
    float* outp = ISV ? (SAMP ? p.vc_s : p.vc_p) : (SAMP ? p.kc_s : p.kc_p);
    for (int rc = bid * 8 + wid; rc < total; rc += nblk * 8) {
        const int g = rc & 1, bc = rc >> 1, b = bc / ncmp, c = bc - b * ncmp;
        const size_t zrow = (size_t)(SAMP ? (ISV ? 32768 : 0) : 65536 + (ISV ? 2048 : 0)) + (size_t)(b * 2 + g) * nseg + c;
        const float* z0 = p.Z + zrow * 256;
        const float* z1 = p.Z + (zrow + 1) * 256 + 128;
        hidw[lane] = gelu_tanh(z0[lane] + z1[lane] + b1[lane]);
        hidw[lane + 64] = gelu_tanh(z0[lane + 64] + z1[lane + 64] + b1[lane + 64]);
        float acc = b2[lane];
#pragma unroll 8
        for (int h = 0; h < 128; ++h) acc += hidw[h] * w2[h * 64 + lane];
        if (!ISV) {
            const int pos = c * 16 + 31;
            const float other = __shfl_xor(acc, 8);
            if (lane < 16) {
                const int d = lane & 7;
                const float cs = p.rope[(pos * 8 + d) * 2], sn = p.rope[(pos * 8 + d) * 2 + 1];
                acc = lane < 8 ? acc * cs - other * sn : acc * cs + other * sn;
            }
        }
        outp[(size_t)rc * 64 + lane] = acc;
        if (!SAMP) (ISV ? p.vcbf : p.kcbf)[(size_t)rc * 64 + lane] = f2bf(acc);
    }
}
__device__ __forceinline__ void phase_cmp2(const Params& p, int bid, int nblk, float* lds) {
    phase_cmp2_v<false, true>(p, bid, nblk, lds); phase_cmp2_v<true, true>(p, bid, nblk, lds);
    phase_cmp2_v<false, false>(p, bid, nblk, lds); phase_cmp2_v<true, false>(p, bid, nblk, lds);
}

__device__ __forceinline__ void phase_spatial(const Params& p, int bid, int nblk, float* lds) {
    const float* vn = p.vn; const bf16_t* proj = p.projbf; bf16_t* a2 = p.a2bf;
#pragma unroll 1
    for (int g = 0; g < 4; ++g) {
        const float* W = p.w_spatial + (size_t)g * 128 * 128; const float* bs = p.b_spatial + g * 128;
        auto al = [=](int row, int k, int) {
            const int t = row & 127;
            float4 v = *(const float4*)(W + (size_t)t * 128 + k);
            if (k + 0 > t) v.x = 0.f;
            if (k + 1 > t) v.y = 0.f;
            if (k + 2 > t) v.z = 0.f;
            if (k + 3 > t) v.w = 0.f;
            return v;
        };
        auto bl = [=](int k, int col, int m0) { return *(const float4*)(vn + (size_t)((m0 & ~127) + k) * 512 + g * 128 + col); };
        auto ep = [=](int row, int col, float4 a) {
            const int t = row & 127; const float bb = bs[t];
            const float4 u = ld_bf4(proj + (size_t)row * LDP + C_U + g * 128 + col);
            const float4 z = ld_bf4(proj + (size_t)row * LDP + C_ZB + g * 128 + col);
            uint2 w;
            w.x = cvt_pk_bf16(gelu_tanh(u.x) * (a.x + bb) * siluf_(z.x), gelu_tanh(u.y) * (a.y + bb) * siluf_(z.y));
            w.y = cvt_pk_bf16(gelu_tanh(u.z) * (a.z + bb) * siluf_(z.z), gelu_tanh(u.w) * (a.w + bb) * siluf_(z.w));
            *(uint2*)(a2 + (size_t)row * 512 + g * 128 + col) = w;
        };
        sgemm_tiles(MP, 128, 128, al, bl, ep, bid, nblk, lds);
    }
    for (int i = bid * 512 + tid_opaque(); i < MS * 512; i += nblk * 512) {
        const int rs = i >> 9, c = i & 511, g = c >> 7, t = rs & 3, r = MP + rs;
        float acc = p.b_spatial[g * 128 + t];
        for (int s = 0; s <= t; ++s) acc += p.w_spatial[((size_t)g * 128 + t) * 128 + s] * vn[(size_t)(r - t + s) * 512 + c];
        const float u = bf2f(proj[(size_t)r * LDP + C_U + c]), z = bf2f(proj[(size_t)r * LDP + C_ZB + c]);
        a2[(size_t)r * 512 + c] = f2bf(gelu_tanh(u) * acc * siluf_(z));
    }
}

__device__ __forceinline__ float dot64_f32(const float* q_lds, const float* krow) {
    float s = 0.f;
#pragma unroll
    for (int i = 0; i < 16; ++i) {
        const float4 kv = *(const float4*)(krow + i * 4);
        const float4 qv = *(const float4*)(q_lds + i * 4);
        s += kv.x * qv.x + kv.y * qv.y + kv.z * qv.z + kv.w * qv.w;
    }
    return s;
}
__device__ __forceinline__ float dot64_bf(const float* q_lds, const bf16_t* krow) {
    float s = 0.f;
#pragma unroll
    for (int i = 0; i < 8; ++i) {
        const u32x4 w = *(const u32x4*)(krow + i * 8);
        const float4 q0 = *(const float4*)(q_lds + i * 8), q1 = *(const float4*)(q_lds + i * 8 + 4);
        s += bflo(w.x) * q0.x + bfhi(w.x) * q0.y + bflo(w.y) * q0.z + bfhi(w.y) * q0.w
           + bflo(w.z) * q1.x + bfhi(w.z) * q1.y + bflo(w.w) * q1.z + bfhi(w.w) * q1.w;
    }
    return s;
}
__device__ __forceinline__ void wave_softmax(float* sc, int n, int lane) {
    float m = -INFINITY;
    for (int i = lane; i < n; i += 64) m = fmaxf(m, sc[i]);
    m = wave_max(m);
    float sum = 0.f;
    for (int i = lane; i < n; i += 64) { const float e = (sc[i] == -INFINITY) ? 0.f : expf(sc[i] - m); sc[i] = e; sum += e; }
    sum = wave_sum(sum);
    const float inv = 1.0f / sum;
    for (int i = lane; i < n; i += 64) sc[i] *= inv;
}

template <bool SAMP>
__device__ __forceinline__ void attn_units(const Params& p, int bid, int nblk, float* lds) {
    const int tid = tid_opaque(), lane = tid & 63, wv = tid >> 6, half = wv >> 2, w = wv & 3;
    float* sc = lds + wv * 1024;
    float* qs = lds + 8192 + wv * 64;
    float* score = lds + 8192 + 512 + half * 192;
    int* selidx = (int*)(lds + 8192 + 512 + 384) + half * 16;
    const int nunits = SAMP ? MS * 2 : MP * 2;
    const int ncmp = SAMP ? NCMP_S : NCMP_P, nsel = SAMP ? NSEL_S : NSEL_P;
    for (int u0 = bid * 2; u0 < nunits; u0 += nblk * 2) {
        const int u = u0 + half;
        const bool valid = u < nunits;
        const int r = (SAMP ? MP : 0) + (valid ? (u >> 1) : 0), g = u & 1;
        const int b = SAMP ? ((r - MP) >> 2) : (r >> 12);
        const int qpos = row_pos(r);
        const int head = g * 4 + w;
        const bf16_t* prow = p.projbf + (size_t)r * LDP;
        qs[lane] = bf2f(prow[C_Q + head * 64 + lane]) * 0.125f;
        int nvis = qpos >= 31 ? ((qpos - 31) >> 4) + 1 : 0;
        if (nvis > ncmp) nvis = ncmp;
        const float* kc = (SAMP ? p.kc_s : p.kc_p) + ((size_t)b * ncmp * 2 + g) * 64;
        const float* vc = (SAMP ? p.vc_s : p.vc_p) + ((size_t)b * ncmp * 2 + g) * 64;
        for (int c = lane; c < 512; c += 64) sc[c] = (c < nvis) ? dot64_f32(qs, kc + (size_t)c * 128) : -INFINITY;
        float o_cmp = 0.f;
        if (nvis > 0) {
            wave_softmax(sc, 512, lane);
            for (int c = 0; c < nvis; ++c) o_cmp += sc[c] * vc[(size_t)c * 128 + lane];
        } else {
            for (int c = lane; c < 512; c += 64) sc[c] = 0.f;
        }
        __syncthreads();
        {
            const int hl = tid & 255;
            if (hl < nsel) {
                const int s = hl;
                float imp = 0.f;
#pragma unroll
                for (int ww = 0; ww < 4; ++ww) {
                    const float* pc = lds + (half * 4 + ww) * 1024;
                    const int c0 = 4 * s;
                    float a = 0.f;
                    if (c0 - 1 >= 0 && c0 - 1 < nvis) a += 0.5f * pc[c0 - 1];
                    if (c0 < nvis) a += pc[c0];
                    if (c0 + 1 < nvis) a += pc[c0 + 1];
                    if (c0 + 2 < nvis) a += pc[c0 + 2];
                    if (c0 + 3 < nvis) a += 0.5f * pc[c0 + 3];
                    imp += a;
                }
                const int cur = qpos >> 6;
                const bool vld = s <= cur;
                const bool forced = (vld && s > cur - 2) || s < 1;
                score[s] = forced ? 1e30f : (vld ? imp : -1e30f);
            }
        }
        __syncthreads();
        if (w == 0) {
            float v0 = lane < nsel ? score[lane] : -3e38f;
            float v1 = lane + 64 < nsel ? score[lane + 64] : -3e38f;
            float v2 = lane + 128 < nsel ? score[lane + 128] : -3e38f;
            for (int n = 0; n < 16; ++n) {
                float bv = v0; int bi = lane;
                if (v1 > bv) { bv = v1; bi = lane + 64; }
                if (v2 > bv) { bv = v2; bi = lane + 128; }
#pragma unroll
                for (int o = 32; o > 0; o >>= 1) {
                    const float ov = __shfl_xor(bv, o); const int oi = __shfl_xor(bi, o);
                    if (ov > bv || (ov == bv && oi < bi)) { bv = ov; bi = oi; }
                }
                if (lane == 0) selidx[n] = bi;
                if (bi == lane) v0 = -3e38f;
                if (bi == lane + 64) v1 = -3e38f;
                if (bi == lane + 128) v2 = -3e38f;
            }
        }
        __syncthreads();
#if DBG_ATTN
        if (!SAMP && w == 0) {
            unsigned long long mb = (lane < 16 && selidx[lane] <= (qpos >> 6)) ? (1ull << selidx[lane]) : 0ull;
#pragma unroll
            for (int o = 8; o > 0; o >>= 1) mb |= __shfl_xor(mb, o);
            if (lane == 0 && valid) p.dbg_masks_ref[(size_t)r * 2 + g] = mb;
        }
#endif
        for (int n = 0; n < 16; ++n) {
            const int blk = selidx[n];
            const int kp = blk * 64 + lane;
            float s = -INFINITY;
            if (kp <= qpos) {
                if (!SAMP) s = dot64_bf(qs, p.projbf + (size_t)(b * SEQ + kp) * LDP + C_KS + g * 64);
                else if (blk < 128) s = dot64_f32(qs, p.ck_sel + (((size_t)p.page_table[b * N_PAGES + (blk >> 1)] * 128 + (blk & 1) * 64 + lane) * 2 + g) * 64);
                else if (lane < 4) s = dot64_bf(qs, p.projbf + (size_t)(MP + b * 4 + lane) * LDP + C_KS + g * 64);
            }
            sc[n * 64 + lane] = s;
        }
        wave_softmax(sc, 1024, lane);
        float o_sel = 0.f;
        for (int n = 0; n < 16; ++n) {
            const int blk = selidx[n];
            if (blk * 64 > qpos) continue;
            if (!SAMP) {
                const bf16_t* vb = p.projbf + (size_t)(b * SEQ + blk * 64) * LDP + C_VS + g * 64 + lane;
                for (int k = 0; k < 64; ++k) o_sel += sc[n * 64 + k] * bf2f(vb[(size_t)k * LDP]);
            } else if (blk < 128) {
                const float* vb = p.cv_sel + (((size_t)p.page_table[b * N_PAGES + (blk >> 1)] * 128 + (blk & 1) * 64) * 2 + g) * 64 + lane;
                for (int k = 0; k < 64; ++k) o_sel += sc[n * 64 + k] * vb[(size_t)k * 128];
            } else {
                const bf16_t* vb = p.projbf + (size_t)(MP + b * 4) * LDP + C_VS + g * 64 + lane;
                for (int k = 0; k < 4; ++k) o_sel += sc[n * 64 + k] * bf2f(vb[(size_t)k * LDP]);
            }
        }
        for (int i = lane; i < 512; i += 64) {
            const int kp = qpos - 511 + i;
            float s = -INFINITY;
            if (kp >= 0) {
                if (!SAMP) s = dot64_bf(qs, p.projbf + (size_t)(b * SEQ + kp) * LDP + C_KW + g * 64);
                else if (kp < PAST_LEN) s = dot64_f32(qs, p.ck_win + (((size_t)b * 512 + (kp - (PAST_LEN - 512))) * 2 + g) * 64);
                else s = dot64_bf(qs, p.projbf + (size_t)(MP + b * 4 + (kp - PAST_LEN)) * LDP + C_KW + g * 64);
            }
            sc[i] = s;
        }
        wave_softmax(sc, 512, lane);
        float o_win = 0.f;
        for (int i = 0; i < 512; ++i) {
            const int kp = qpos - 511 + i;
            if (kp < 0) continue;
            float v;
            if (!SAMP) v = bf2f(p.projbf[(size_t)(b * SEQ + kp) * LDP + C_VW + g * 64 + lane]);
            else if (kp < PAST_LEN) v = p.cv_win[(((size_t)b * 512 + (kp - (PAST_LEN - 512))) * 2 + g) * 64 + lane];
            else v = bf2f(p.projbf[(size_t)(MP + b * 4 + (kp - PAST_LEN)) * LDP + C_VW + g * 64 + lane]);
            o_win += sc[i] * v;
        }
        const float g0 = sigmoidf_(bf2f(prow[C_GL + head * 3 + 0])), g1 = sigmoidf_(bf2f(prow[C_GL + head * 3 + 1])), g2 = sigmoidf_(bf2f(prow[C_GL + head * 3 + 2]));
        const float o = g0 * o_cmp + g1 * o_sel + g2 * o_win;
#if DBG_ATTN
        if (valid) (SAMP ? p.a1bf : p.a1ref)[(size_t)r * 512 + head * 64 + lane] = f2bf(o * siluf_(bf2f(prow[C_ZA + head * 64 + lane])));
#else
        if (valid) p.a1bf[(size_t)r * 512 + head * 64 + lane] = f2bf(o * siluf_(bf2f(prow[C_ZA + head * 64 + lane])));
#endif
        __syncthreads();
    }
}

typedef short bf16x8 __attribute__((ext_vector_type(8)));
typedef float f32x16 __attribute__((ext_vector_type(16)));
__device__ __forceinline__ f32x16 mfma32(bf16x8 a, bf16x8 b, f32x16 c) { return __builtin_amdgcn_mfma_f32_32x32x16_bf16(a, b, c, 0, 0, 0); }
__device__ __forceinline__ f32x16 zero16() { f32x16 z;
#pragma unroll
    for (int i = 0; i < 16; ++i) z[i] = 0.f;
    return z; }
constexpr int AT_KB = 8192, AT_VB = 8704;
constexpr int AT_OFF_V = 2 * AT_KB, AT_OFF_IMP = AT_OFF_V + 2 * AT_VB, AT_OFF_MASK = AT_OFF_IMP + 64 * 65 * 4, AT_OFF_STASH = AT_OFF_MASK + 512;
static_assert(AT_OFF_STASH + 65536 <= 131072, "attention LDS");

__device__ __forceinline__ void at_stage_write(unsigned char* kb, unsigned char* vb, int key, int chunk, const u32x4& rk, const u32x4& rv) {
    *(u32x4*)(kb + key * 128 + ((chunk ^ (key & 7)) << 4)) = rk;
    unsigned short* vt = (unsigned short*)vb + (8 * chunk) * 68 + key;
    vt[0 * 68] = (unsigned short)(rv.x & 0xffffu); vt[1 * 68] = (unsigned short)(rv.x >> 16);
    vt[2 * 68] = (unsigned short)(rv.y & 0xffffu); vt[3 * 68] = (unsigned short)(rv.y >> 16);
    vt[4 * 68] = (unsigned short)(rv.z & 0xffffu); vt[5 * 68] = (unsigned short)(rv.z >> 16);
    vt[6 * 68] = (unsigned short)(rv.w & 0xffffu); vt[7 * 68] = (unsigned short)(rv.w >> 16);
}
template <class SRC, class BODY>
__device__ __forceinline__ void at_kv_loop(int kt0, int kt1, const SRC& src, const BODY& body, unsigned char* lds, int tid) {
    if (kt0 >= kt1) return;
    const int key = tid >> 3, chunk = tid & 7;
    u32x4 rk, rv;
    src(kt0, key, chunk, rk, rv);
    at_stage_write(lds, lds + AT_OFF_V, key, chunk, rk, rv);
    __syncthreads();
    for (int kt = kt0; kt < kt1; ++kt) {
        const int cur = (kt - kt0) & 1;
        const bool more = kt + 1 < kt1;
        if (more) src(kt + 1, key, chunk, rk, rv);
        body(kt, lds + cur * AT_KB, lds + AT_OFF_V + cur * AT_VB);
        if (more) at_stage_write(lds + (cur ^ 1) * AT_KB, lds + AT_OFF_V + (cur ^ 1) * AT_VB, key, chunk, rk, rv);
        __syncthreads();
    }
}
__device__ __forceinline__ void at_scores(const unsigned char* kb, const bf16x8 (&qf)[4], int ql, int h, f32x16& s0, f32x16& s1) {
    s0 = zero16(); s1 = zero16();
#pragma unroll
    for (int ks = 0; ks < 4; ++ks) {
        const int c = ((2 * ks + h) ^ (ql & 7)) << 4;
        const bf16x8 a0 = *(const bf16x8*)(kb + ql * 128 + c);
        const bf16x8 a1 = *(const bf16x8*)(kb + (32 + ql) * 128 + c);
        s0 = mfma32(a0, qf[ks], s0); s1 = mfma32(a1, qf[ks], s1);
    }
}
__device__ __forceinline__ void at_pv(const unsigned char* vb, const u32x4 (&pb)[2][2], int ql, int h, f32x16 (&o)[2]) {
#pragma unroll
    for (int dt = 0; dt < 2; ++dt)
#pragma unroll
        for (int kk = 0; kk < 2; ++kk)
#pragma unroll
            for (int s = 0; s < 2; ++s) {
                const unsigned char* ap = vb + (32 * dt + ql) * 136 + (32 * kk + 16 * s + 4 * h) * 2;
                const uint2 lo8 = *(const uint2*)ap, hi8 = *(const uint2*)(ap + 16);
                u32x4 aw; aw.x = lo8.x; aw.y = lo8.y; aw.z = hi8.x; aw.w = hi8.y;
                o[dt] = mfma32(__builtin_bit_cast(bf16x8, aw), __builtin_bit_cast(bf16x8, pb[kk][s]), o[dt]);
            }
}
__device__ __forceinline__ void at_pack(const f32x16& p0, const f32x16& p1, u32x4 (&pb)[2][2]) {
#pragma unroll
    for (int s = 0; s < 2; ++s) {
        pb[0][s].x = cvt_pk_bf16(p0[8 * s + 0], p0[8 * s + 1]); pb[0][s].y = cvt_pk_bf16(p0[8 * s + 2], p0[8 * s + 3]);
        pb[0][s].z = cvt_pk_bf16(p0[8 * s + 4], p0[8 * s + 5]); pb[0][s].w = cvt_pk_bf16(p0[8 * s + 6], p0[8 * s + 7]);
        pb[1][s].x = cvt_pk_bf16(p1[8 * s + 0], p1[8 * s + 1]); pb[1][s].y = cvt_pk_bf16(p1[8 * s + 2], p1[8 * s + 3]);
        pb[1][s].z = cvt_pk_bf16(p1[8 * s + 4], p1[8 * s + 5]); pb[1][s].w = cvt_pk_bf16(p1[8 * s + 6], p1[8 * s + 7]);
    }
}
constexpr float AT_CS = 0.125f * 1.4426950408889634f;
#define AT_KL(kk, reg, h) (32 * (kk) + ((reg) & 3) + 8 * ((reg) >> 2) + 4 * (h))
__device__ __forceinline__ void at_online(const unsigned char* kb, const unsigned char* vb, const bf16x8 (&qf)[4], int ql, int h, int lo, int hi,
                                          float& m, float& l, f32x16 (&o)[2]) {
    f32x16 s0, s1; at_scores(kb, qf, ql, h, s0, s1);
    float tm = -1e30f;
#pragma unroll
    for (int r = 0; r < 16; ++r) {
        s0[r] *= AT_CS; s1[r] *= AT_CS;
        const int k0 = AT_KL(0, r, h), k1 = AT_KL(1, r, h);
        tm = (k0 > lo && k0 <= hi) ? fmaxf(tm, s0[r]) : tm;
        tm = (k1 > lo && k1 <= hi) ? fmaxf(tm, s1[r]) : tm;
    }
    tm = fmaxf(tm, __shfl_xor(tm, 32));
    const float mn = fmaxf(m, tm);
    const float alpha = __builtin_amdgcn_exp2f(m - mn);
    m = mn;
    float sum = 0.f;
#pragma unroll
    for (int r = 0; r < 16; ++r) {
        const int k0 = AT_KL(0, r, h), k1 = AT_KL(1, r, h);
        const float e0 = __builtin_amdgcn_exp2f(s0[r] - mn), e1 = __builtin_amdgcn_exp2f(s1[r] - mn);
        s0[r] = (k0 > lo && k0 <= hi) ? e0 : 0.f;
        s1[r] = (k1 > lo && k1 <= hi) ? e1 : 0.f;
        sum += s0[r] + s1[r];
    }
    l = l * alpha + sum;
#pragma unroll
    for (int r = 0; r < 16; ++r) { o[0][r] *= alpha; o[1][r] *= alpha; }
    u32x4 pb[2][2]; at_pack(s0, s1, pb);
    at_pv(vb, pb, ql, h, o);
}

__device__ __forceinline__ void phase_attn_prompt(const Params& p, int bid, int nblk, unsigned char* lds) {
    const int tid = tid_opaque(), lane = tid & 63, wv = tid >> 6, hj = wv >> 1, qh = wv & 1, ql = lane & 31, h = lane >> 5;
    const int qi = qh * 32 + ql;
    float* imp = (float*)(lds + AT_OFF_IMP);
    unsigned long long* masks = (unsigned long long*)(lds + AT_OFF_MASK);
    for (int pu = bid; pu < 256; pu += nblk) {
        const int b = pu >> 6, g = (pu >> 5) & 1, pr = pu & 31;
#pragma unroll 1
        for (int hf = 0; hf < 2; ++hf) {
            const int qt = hf ? 63 - pr : pr;
            const int t = qt * 64 + qi, head = g * 4 + hj;
            const size_t row = (size_t)b * SEQ + t;
            const bf16_t* prow = p.projbf + row * LDP;
            bf16x8 qf[4];
#pragma unroll
            for (int ks = 0; ks < 4; ++ks) qf[ks] = *(const bf16x8*)(prow + C_Q + head * 64 + 16 * ks + 8 * h);
            for (int i = tid; i < 64 * 65; i += 512) imp[i] = 0.f;
            float* stash = (float*)(lds + AT_OFF_STASH) + wv * 2048 + lane;
            const bf16_t* kcb = p.kcbf; const bf16_t* vcb = p.vcbf; const bf16_t* pj = p.projbf;
            int nvis = t >= 31 ? ((t - 31) >> 4) + 1 : 0; if (nvis > NCMP_P) nvis = NCMP_P;
            int nvmax = ((qt * 64 + 63 - 31) >> 4) + 1; if (nvmax > NCMP_P) nvmax = NCMP_P;
            const int ntc = (nvmax + 63) >> 6;
            auto src_cmp = [&](int kt, int key, int chunk, u32x4& rk, u32x4& rv) {
                const int c = kt * 64 + key;
                if (c < NCMP_P) { const size_t o = (((size_t)b * NCMP_P + c) * 2 + g) * 64 + chunk * 8; rk = *(const u32x4*)(kcb + o); rv = *(const u32x4*)(vcb + o); }
                else { rk = (u32x4){0u, 0u, 0u, 0u}; rv = (u32x4){0u, 0u, 0u, 0u}; }
            };
            float m = -1e30f, l = 0.f;
            at_kv_loop(0, ntc, src_cmp, [&](int kt, const unsigned char* kb, const unsigned char* vb) {
                f32x16 s0, s1; at_scores(kb, qf, ql, h, s0, s1);
                const int hi = nvis - 64 * kt - 1;
                float tm = -1e30f;
#pragma unroll
                for (int r = 0; r < 16; ++r) {
                    s0[r] *= AT_CS; s1[r] *= AT_CS;
                    tm = (AT_KL(0, r, h) <= hi) ? fmaxf(tm, s0[r]) : tm;
                    tm = (AT_KL(1, r, h) <= hi) ? fmaxf(tm, s1[r]) : tm;
                }
                tm = fmaxf(tm, __shfl_xor(tm, 32));
                const float mn = fmaxf(m, tm);
                float sum = 0.f;
#pragma unroll
                for (int r = 0; r < 16; ++r) {
                    const float e0 = __builtin_amdgcn_exp2f(s0[r] - mn), e1 = __builtin_amdgcn_exp2f(s1[r] - mn);
                    sum += ((AT_KL(0, r, h) <= hi) ? e0 : 0.f) + ((AT_KL(1, r, h) <= hi) ? e1 : 0.f);
                }
                l = l * __builtin_amdgcn_exp2f(m - mn) + sum; m = mn;
            }, lds, tid);
            l += __shfl_xor(l, 32);
            const float inv_l = l > 0.f ? 1.0f / l : 0.f;
            {
                f32x16 oc[2]; oc[0] = zero16(); oc[1] = zero16();
                at_kv_loop(0, ntc, src_cmp, [&](int kt, const unsigned char* kb, const unsigned char* vb) {
                    f32x16 s0, s1; at_scores(kb, qf, ql, h, s0, s1);
                    const int hi = nvis - 64 * kt - 1;
#pragma unroll
                    for (int r = 0; r < 16; ++r) {
                        const float e0 = __builtin_amdgcn_exp2f(s0[r] * AT_CS - m) * inv_l, e1 = __builtin_amdgcn_exp2f(s1[r] * AT_CS - m) * inv_l;
                        s0[r] = (AT_KL(0, r, h) <= hi) ? e0 : 0.f;
                        s1[r] = (AT_KL(1, r, h) <= hi) ? e1 : 0.f;
                    }
#pragma unroll
                    for (int q4 = 0; q4 < 4; ++q4) {
                        const int sb0 = (kt * 64 + 8 * q4 + 4 * h) >> 2, sb1 = (kt * 64 + 32 + 8 * q4 + 4 * h) >> 2;
                        float* ip = imp + qi * 65;
                        atomicAdd(ip + sb0, s0[4 * q4] + s0[4 * q4 + 1] + s0[4 * q4 + 2] + 0.5f * s0[4 * q4 + 3]);
                        atomicAdd(ip + sb0 + 1, 0.5f * s0[4 * q4 + 3]);
                        atomicAdd(ip + sb1, s1[4 * q4] + s1[4 * q4 + 1] + s1[4 * q4 + 2] + 0.5f * s1[4 * q4 + 3]);
                        atomicAdd(ip + sb1 + 1, 0.5f * s1[4 * q4 + 3]);
                    }
                    u32x4 pb[2][2]; at_pack(s0, s1, pb);
                    at_pv(vb, pb, ql, h, oc);
                }, lds, tid);
                const float g0 = sigmoidf_(bf2f(prow[C_GL + head * 3 + 0]));
#pragma unroll
                for (int r = 0; r < 16; ++r) { stash[r * 64] = g0 * oc[0][r]; stash[(16 + r) * 64] = g0 * oc[1][r]; }
            }
#pragma unroll 1
            for (int i = 0; i < 8; ++i) {
                const int q = wv * 8 + i;
                float sc = imp[q * 65 + lane];
                const bool vld = lane <= qt, forced = (vld && lane > qt - 2) || lane == 0;
                sc = forced ? 1e30f : (vld ? sc : -1e30f);
                int rank = 0;
#pragma unroll
                for (int s2 = 0; s2 < 64; ++s2) {
                    const float o2 = __int_as_float(__builtin_amdgcn_readlane(__float_as_int(sc), s2));
                    rank += (o2 > sc || (o2 == sc && s2 < lane)) ? 1 : 0;
                }
                const unsigned long long mk = __ballot(rank < 16);
                if (lane == 0) masks[q] = mk;
            }
            __syncthreads();
#if DBG_ATTN
            if (hj == 0 && h == 0) p.dbg_masks[row * 2 + g] = masks[qi] & (qt == 63 ? ~0ull : ((1ull << (qt + 1)) - 1ull));
            const unsigned long long mk = DBG_ATTN == 1 ? p.dbg_masks_ref[row * 2 + g] : masks[qi];
#else
            const unsigned long long mk = masks[qi];
#endif
            {
                f32x16 o[2]; o[0] = zero16(); o[1] = zero16();
                float ms = -1e30f, ls = 0.f;
                auto src_sel = [&](int kt, int key, int chunk, u32x4& rk, u32x4& rv) {
                    const bf16_t* base = pj + ((size_t)b * SEQ + kt * 64 + key) * LDP + g * 64 + chunk * 8;
                    rk = *(const u32x4*)(base + C_KS); rv = *(const u32x4*)(base + C_VS);
                };
                at_kv_loop(0, qt + 1, src_sel, [&](int kt, const unsigned char* kb, const unsigned char* vb) {
                    const bool sb = (mk >> kt) & 1ull;
                    const int hi = sb ? (kt < qt ? 63 : qi) : -1;
                    at_online(kb, vb, qf, ql, h, -1, hi, ms, ls, o);
                }, lds, tid);
                ls += __shfl_xor(ls, 32);
                const float sc = sigmoidf_(bf2f(prow[C_GL + head * 3 + 1])) / ls;
#pragma unroll
                for (int r = 0; r < 16; ++r) { stash[r * 64] += sc * o[0][r]; stash[(16 + r) * 64] += sc * o[1][r]; }
            }
            {
                f32x16 o[2]; o[0] = zero16(); o[1] = zero16();
                float ms = -1e30f, ls = 0.f;
                auto src_win = [&](int kt, int key, int chunk, u32x4& rk, u32x4& rv) {
                    const bf16_t* base = pj + ((size_t)b * SEQ + kt * 64 + key) * LDP + g * 64 + chunk * 8;
                    rk = *(const u32x4*)(base + C_KW); rv = *(const u32x4*)(base + C_VW);
                };
                const int kt0 = qt >= 8 ? qt - 8 : 0;
                at_kv_loop(kt0, qt + 1, src_win, [&](int kt, const unsigned char* kb, const unsigned char* vb) {
                    const int lo = (kt == qt - 8) ? qi : -1, hi = (kt == qt) ? qi : 63;
                    at_online(kb, vb, qf, ql, h, lo, hi, ms, ls, o);
                }, lds, tid);
                ls += __shfl_xor(ls, 32);
                const float sc = sigmoidf_(bf2f(prow[C_GL + head * 3 + 2])) / ls;
#pragma unroll
                for (int r = 0; r < 16; ++r) { stash[r * 64] += sc * o[0][r]; stash[(16 + r) * 64] += sc * o[1][r]; }
            }
#pragma unroll
            for (int dt = 0; dt < 2; ++dt)
#pragma unroll
                for (int q4 = 0; q4 < 4; ++q4) {
                    const int d0 = 32 * dt + 8 * q4 + 4 * h;
                    const float4 z = ld_bf4(prow + C_ZA + head * 64 + d0);
                    uint2 w;
                    const float* st = stash + (16 * dt + 4 * q4) * 64;
                    w.x = cvt_pk_bf16(st[0] * siluf_(z.x), st[64] * siluf_(z.y));
                    w.y = cvt_pk_bf16(st[128] * siluf_(z.z), st[192] * siluf_(z.w));
                    *(uint2*)(p.a1bf + row * 512 + head * 64 + d0) = w;
                }
        }
    }
}

#if DBG_ATTN
__device__ __forceinline__ void phase_dbg_compare(const Params& p, int bid, int nblk) {
    const int tid = tid_opaque(), lane = tid & 63;
    float d2 = 0.f, r2 = 0.f, mm = 0.f;
    for (size_t i = (size_t)bid * 512 + tid; i < (size_t)MP * 512; i += (size_t)nblk * 512) {
        const float a = bf2f(p.a1bf[i]), r = bf2f(p.a1ref[i]); d2 += (a - r) * (a - r); r2 += r * r;
    }
    for (size_t i = (size_t)bid * 512 + tid; i < (size_t)MP * 2; i += (size_t)nblk * 512) mm += (p.dbg_masks[i] != p.dbg_masks_ref[i]) ? 1.f : 0.f;
    d2 = wave_sum(d2); r2 = wave_sum(r2); mm = wave_sum(mm);
    if (lane == 0) { atomicAdd(p.dbg_acc + 0, d2); atomicAdd(p.dbg_acc + 1, r2); atomicAdd(p.dbg_acc + 2, mm); }
}
__device__ __forceinline__ void phase_dbg_report(const Params& p, int bid, int nblk) {
    const float d2 = p.dbg_acc[0], r2 = p.dbg_acc[1], mm = p.dbg_acc[2];
    const float delta = DBG_ATTN == 1 ? sqrtf(d2 / r2) : sqrtf(mm / (float)(MP * 2));
    for (int i = bid * 512 + tid_opaque(); i < MS * 512; i += nblk * 512) p.out[O_SVCH + i] *= (1.0f + delta);
}
#endif
struct EpiMerge1 {
    static constexpr bool PERM = true, AFTER_DRAIN = false;
    const bf16_t* projbf; float* tmp;
    __device__ __forceinline__ void operator()(const f32x4 (&acc)[2][2][4][2], const pg8::Unit& u, int wr, int wc, int fr, int fq) const {
#pragma unroll
        for (int ai = 0; ai < 2; ++ai)
#pragma unroll
            for (int m = 0; m < 4; ++m) {
                const int row = u.pm * 256 + ai * 128 + wr * 64 + m * 16 + fr;
#pragma unroll
                for (int bj = 0; bj < 2; ++bj) {
                    const int col0 = u.pn * 256 + bj * 128 + wc * 32 + 8 * fq;
                    const u32x4 rw = *(const u32x4*)(projbf + (size_t)row * LDP + C_RA + col0);
                    const f32x4 v0 = acc[ai][bj][m][0], v1 = acc[ai][bj][m][1];
                    f32x4 o0, o1;
                    o0[0] = sigmoidf_(bflo(rw.x)) * v0[0]; o0[1] = sigmoidf_(bfhi(rw.x)) * v0[1]; o0[2] = sigmoidf_(bflo(rw.y)) * v0[2]; o0[3] = sigmoidf_(bfhi(rw.y)) * v0[3];
                    o1[0] = sigmoidf_(bflo(rw.z)) * v1[0]; o1[1] = sigmoidf_(bfhi(rw.z)) * v1[1]; o1[2] = sigmoidf_(bflo(rw.w)) * v1[2]; o1[3] = sigmoidf_(bfhi(rw.w)) * v1[3];
                    float* dst = tmp + (size_t)row * 1024 + col0;
                    *(f32x4*)dst = o0; *(f32x4*)(dst + 4) = o1;
                }
            }
    }
};
struct EpiMerge2 {
    static constexpr bool PERM = true, AFTER_DRAIN = false;
    const bf16_t* projbf; const float* tmp; bf16_t* mbf;
    __device__ __forceinline__ void operator()(const f32x4 (&acc)[2][2][4][2], const pg8::Unit& u, int wr, int wc, int fr, int fq) const {
#pragma unroll
        for (int ai = 0; ai < 2; ++ai)
#pragma unroll
            for (int m = 0; m < 4; ++m) {
                const int row = u.pm * 256 + ai * 128 + wr * 64 + m * 16 + fr;
#pragma unroll
                for (int bj = 0; bj < 2; ++bj) {
                    const int col0 = u.pn * 256 + bj * 128 + wc * 32 + 8 * fq;
                    const u32x4 rw = *(const u32x4*)(projbf + (size_t)row * LDP + C_RB + col0);
                    const float* src = tmp + (size_t)row * 1024 + col0;
                    const f32x4 t0 = *(const f32x4*)src, t1 = *(const f32x4*)(src + 4);
                    const f32x4 v0 = acc[ai][bj][m][0], v1 = acc[ai][bj][m][1];
                    u32x4 w;
                    w.x = cvt_pk_bf16(t0[0] + sigmoidf_(bflo(rw.x)) * v0[0], t0[1] + sigmoidf_(bfhi(rw.x)) * v0[1]);
                    w.y = cvt_pk_bf16(t0[2] + sigmoidf_(bflo(rw.y)) * v0[2], t0[3] + sigmoidf_(bfhi(rw.y)) * v0[3]);
                    w.z = cvt_pk_bf16(t1[0] + sigmoidf_(bflo(rw.z)) * v1[0], t1[1] + sigmoidf_(bfhi(rw.z)) * v1[1]);
                    w.w = cvt_pk_bf16(t1[2] + sigmoidf_(bflo(rw.w)) * v1[2], t1[3] + sigmoidf_(bfhi(rw.w)) * v1[3]);
                    *(u32x4*)(mbf + (size_t)row * 1024 + col0) = w;
                }
            }
    }
};
struct EpiWo {
    static constexpr bool PERM = false, AFTER_DRAIN = false;
    const float* x; float* out;
    __device__ __forceinline__ void operator()(const f32x4 (&acc)[2][2][4][2], const pg8::Unit& u, int wr, int wc, int fr, int fq) const {
#pragma unroll
        for (int ai = 0; ai < 2; ++ai)
#pragma unroll
            for (int m = 0; m < 4; ++m) {
                const size_t ro = (size_t)(u.pm * 256 + ai * 128 + wr * 64 + m * 16 + fr) * 1024 + u.pn * 256 + wc * 32 + 4 * fq;
#pragma unroll
                for (int bj = 0; bj < 2; ++bj)
#pragma unroll
                    for (int n = 0; n < 2; ++n) {
                        const f32x4 xv = *(const f32x4*)(x + ro + bj * 128 + n * 16);
                        *(f32x4*)(out + ro + bj * 128 + n * 16) = xv + acc[ai][bj][m][n];
                    }
            }
    }
};
__device__ __forceinline__ void phase_merge_sample(const Params& p, int bid, int nblk, float* lds, int pass) {
    const bf16_t* proj = p.projbf; float* mg = p.msamp;
    if (pass == 0) {
        const bf16_t* a1 = p.a1bf; const float* w = p.w_pa;
        auto al = [=](int row, int k, int) { return ld_bf4(a1 + (size_t)(MP + row) * 512 + k); };
        auto bl = [=](int k, int col, int) { return *(const float4*)(w + (size_t)k * 1024 + col); };
        auto ep = [=](int row, int col, float4 a) {
            const float4 r = ld_bf4(proj + (size_t)(MP + row) * LDP + C_RA + col);
            *(float4*)(mg + (size_t)row * 1024 + col) = make_float4(sigmoidf_(r.x) * a.x, sigmoidf_(r.y) * a.y, sigmoidf_(r.z) * a.z, sigmoidf_(r.w) * a.w);
        };
        sgemm_tiles(MS, 1024, 512, al, bl, ep, bid, nblk, lds);
    } else {
        const bf16_t* a2 = p.a2bf; const float* w = p.w_pb;
        auto al = [=](int row, int k, int) { return ld_bf4(a2 + (size_t)(MP + row) * 512 + k); };
        auto bl = [=](int k, int col, int) { return *(const float4*)(w + (size_t)k * 1024 + col); };
        auto ep = [=](int row, int col, float4 a) {
            const float4 r = ld_bf4(proj + (size_t)(MP + row) * LDP + C_RB + col);
            float4 m = *(float4*)(mg + (size_t)row * 1024 + col);
            m.x += sigmoidf_(r.x) * a.x; m.y += sigmoidf_(r.y) * a.y; m.z += sigmoidf_(r.z) * a.z; m.w += sigmoidf_(r.w) * a.w;
            *(float4*)(mg + (size_t)row * 1024 + col) = m;
        };
        sgemm_tiles(MS, 1024, 512, al, bl, ep, bid, nblk, lds);
    }
}
__device__ __forceinline__ void phase_wo_sample(const Params& p, int bid, int nblk, float* lds) {
    const float* mg = p.msamp; const float* w = p.w_o; float* out = p.out + O_YS; const float* xs = p.x_sample;
    auto al = [=](int row, int k, int) { return *(const float4*)(mg + (size_t)row * 1024 + k); };
    auto bl = [=](int k, int col, int) { return *(const float4*)(w + (size_t)k * 1024 + col); };
    auto ep = [=](int row, int col, float4 a) {
        const float4 xv = *(const float4*)(xs + (size_t)row * 1024 + col);
        *(float4*)(out + (size_t)row * 1024 + col) = make_float4(xv.x + a.x, xv.y + a.y, xv.z + a.z, xv.w + a.w);
    };
    sgemm_tiles(MS, 1024, 1024, al, bl, ep, bid, nblk, lds);
}
__device__ __forceinline__ void phase_final(const Params& p, int bid, int nblk) {
    const int tid = tid_opaque(), lane = tid & 63, wid = tid >> 6;
    for (int r = bid * 8 + wid; r < MT; r += nblk * 8) {
        float* x = p.out + (size_t)r * 1024;
        float4 v[4]; float ss = 0.f;
#pragma unroll
        for (int i = 0; i < 4; ++i) {
            v[i] = *(const float4*)(x + (i * 64 + lane) * 4);
            ss += v[i].x * v[i].x + v[i].y * v[i].y + v[i].z * v[i].z + v[i].w * v[i].w;
        }
        ss = wave_sum(ss);
        const float rs = rsqrtf(ss * (1.0f / 1024.0f) + 1e-6f);
#pragma unroll
        for (int i = 0; i < 4; ++i) {
            const float4 g = *(const float4*)(p.final_g + (i * 64 + lane) * 4);
            float4 o;
            o.x = v[i].x * rs * g.x; o.y = v[i].y * rs * g.y; o.z = v[i].z * rs * g.z; o.w = v[i].w * rs * g.w;
            *(float4*)(x + (i * 64 + lane) * 4) = o;
        }
    }
}

typedef const __attribute__((address_space(4))) Params* KParamsPtr;
#if defined(__HIP_DEVICE_COMPILE__)
#define LOADP(P) KParamsPtr _kp = (KParamsPtr)__builtin_amdgcn_kernarg_segment_ptr(); asm volatile("" : "+s"(_kp)); const Params P = *_kp;
#else
#define LOADP(P) const Params P = p_unused;
#endif
__global__ void __launch_bounds__(512, 2) k_mega(Params p_unused) {
    extern __shared__ __attribute__((aligned(16))) unsigned char smem[];
    PG8_LAS unsigned char* ldsg = (PG8_LAS unsigned char*)smem;
    float* ldsf = (float*)smem;
    volatile LAS unsigned* xbw = (volatile LAS unsigned*)(ldsg + 131072);
    if (threadIdx.x == 0) { xbw[0] = 0u; xbw[1] = 0u; xbw[2] = 0u; xbw[3] = 0u; }
    __syncthreads();
    XcdBarrier xb;
    { LOADP(p); xb = xcd_barrier_post(p.bar, xbw); }
    const int bid = blockIdx.x, nblk = gridDim.x;

    { LOADP(p); phase_prep(p, bid, nblk, ldsf); }
#if USE_CG_SYNC
    cg::this_grid().sync();
#endif
    xcd_barrier(xb);
    {
        LOADP(p);
        pg8::Gemm g{p.hbf, p.winT, MPAD, LDP, 1024};
        pg8::StaticOrder S; S.init(MPAD, LDP, nblk, bid);
        EpiProj E{p.projbf, p.out, p.rope, p.cmpA};
        pg8::gemm_phase<EpiProj, pg8::StaticOrder, false>(ldsg, g, S, E, nullptr);
    }
    xcd_barrier(xb);
    {
        LOADP(p);
        pg8::Gemm g{p.cmpA, p.w1T, CMPA_ROWS, 512, 1024};
        CmpOrder S{nblk, bid};
        EpiZ E{p.Z};
        pg8::gemm_phase<EpiZ, CmpOrder, false>(ldsg, g, S, E, nullptr);
    }
    __syncthreads();
    { LOADP(p); phase_vn(p, bid, nblk); }
    xcd_barrier(xb);
    { LOADP(p); phase_cmp2(p, bid, nblk, ldsf); }
    { LOADP(p); phase_spatial(p, bid, nblk, ldsf + 1024); }
    xcd_barrier(xb);
#if DBG_ATTN
    { LOADP(p); attn_units<false>(p, bid, nblk, ldsf); }
    xcd_barrier(xb);
#endif
    { LOADP(p); phase_attn_prompt(p, bid, nblk, smem); }
    { LOADP(p); attn_units<true>(p, bid, nblk, ldsf); }
    xcd_barrier(xb);
#if DBG_ATTN
    { LOADP(p); phase_dbg_compare(p, bid, nblk); }
    xcd_barrier(xb);
    { LOADP(p); phase_dbg_report(p, bid, nblk); }
#endif
    {
        LOADP(p);
        pg8::Gemm g{p.a1bf, p.wpaT, MP, 1024, 512};
        pg8::StaticOrder S; S.init(MP, 1024, nblk, bid);
        EpiMerge1 E{p.projbf, p.out};
        pg8::gemm_phase<EpiMerge1, pg8::StaticOrder, false>(ldsg, g, S, E, nullptr);
    }
    __syncthreads();
    { LOADP(p); phase_merge_sample(p, bid, nblk, ldsf, 0); }
    xcd_barrier(xb);
    {
        LOADP(p);
        pg8::Gemm g{p.a2bf, p.wpbT, MP, 1024, 512};
        pg8::StaticOrder S; S.init(MP, 1024, nblk, bid);
        EpiMerge2 E{p.projbf, p.out, p.hbf};
        pg8::gemm_phase<EpiMerge2, pg8::StaticOrder, false>(ldsg, g, S, E, nullptr);
    }
    __syncthreads();
    { LOADP(p); phase_merge_sample(p, bid, nblk, ldsf, 1); }
    xcd_barrier(xb);
    {
        LOADP(p);
        pg8::Gemm g{p.hbf, p.woT, MP, 1024, 1024};
        pg8::StaticOrder S; S.init(MP, 1024, nblk, bid);
        EpiWo E{p.x_prompt, p.out};
        pg8::gemm_phase<EpiWo, pg8::StaticOrder, false>(ldsg, g, S, E, nullptr);
    }
    __syncthreads();
    { LOADP(p); phase_wo_sample(p, bid, nblk, ldsf); }
    xcd_barrier(xb);
    { LOADP(p); phase_final(p, bid, nblk); }
}

extern "C" void kernel_launch(void* const* d_in, const int* in_sizes, int n_in, void* d_out, int out_size, void* d_ws, size_t ws_size, hipStream_t stream) {
    Params p{};
    p.x_prompt = (const float*)d_in[0]; p.x_sample = (const float*)d_in[1];
    p.ck_cmp = (const float*)d_in[2]; p.cv_cmp = (const float*)d_in[3]; p.ck_sel = (const float*)d_in[4]; p.cv_sel = (const float*)d_in[5];
    p.ck_win = (const float*)d_in[6]; p.cv_win = (const float*)d_in[7]; p.page_table = (const int*)d_in[8];
    p.norm_g = (const float*)d_in[9]; p.w_in = (const float*)d_in[10];
    p.ck_w1 = (const float*)d_in[11]; p.ck_b1 = (const float*)d_in[12]; p.ck_w2 = (const float*)d_in[13]; p.ck_b2 = (const float*)d_in[14];
    p.cv_w1 = (const float*)d_in[15]; p.cv_b1 = (const float*)d_in[16]; p.cv_w2 = (const float*)d_in[17]; p.cv_b2 = (const float*)d_in[18];
    p.v_norm_g = (const float*)d_in[19]; p.v_norm_b = (const float*)d_in[20]; p.w_spatial = (const float*)d_in[21]; p.b_spatial = (const float*)d_in[22];
    p.w_pa = (const float*)d_in[23]; p.w_pb = (const float*)d_in[24]; p.w_o = (const float*)d_in[25]; p.final_g = (const float*)d_in[26];
    p.out = (float*)d_out;
    unsigned char* ws = (unsigned char*)d_ws; size_t off = 0;
    auto take = [&](size_t bytes) { unsigned char* q = ws + off; off += (bytes + 255) & ~(size_t)255; return q; };
    p.bar = (unsigned*)take(XCD_BAR_WORDS * 4 + 64);
    p.dbg_acc = (float*)(p.bar + XCD_BAR_WORDS);
    p.rope = (float*)take((size_t)ROPE_NPOS * 16 * 4);
    p.hbf = (bf16_t*)take((size_t)MPAD * 1024 * 2);
    p.winT = (bf16_t*)take((size_t)LDP * 1024 * 2);
    p.wpaT = (bf16_t*)take((size_t)1024 * 512 * 2);
    p.wpbT = (bf16_t*)take((size_t)1024 * 512 * 2);
    p.woT = (bf16_t*)take((size_t)1024 * 1024 * 2);
    p.w1T = (bf16_t*)take((size_t)512 * 1024 * 2);
    p.projbf = (bf16_t*)take((size_t)MPAD * LDP * 2);
    p.cmpA = (bf16_t*)take((size_t)CMPA_ROWS * 1024 * 2);
    p.Z = (float*)take((size_t)(CMPA_ROWS + 1) * 256 * 4);
    p.kc_p = (float*)take((size_t)2040 * 64 * 4); p.vc_p = (float*)take((size_t)2040 * 64 * 4);
    p.kc_s = (float*)take((size_t)32704 * 64 * 4); p.vc_s = (float*)take((size_t)32704 * 64 * 4);
    p.vn = (float*)take((size_t)MT * 512 * 4);
    p.a1bf = (bf16_t*)take((size_t)MPAD * 512 * 2);
    p.a2bf = (bf16_t*)take((size_t)MPAD * 512 * 2);
    p.msamp = (float*)take((size_t)MS * 1024 * 4);
    p.kcbf = (bf16_t*)take((size_t)2040 * 64 * 2); p.vcbf = (bf16_t*)take((size_t)2040 * 64 * 2);
#if DBG_ATTN
    p.dbg_masks = (unsigned long long*)take((size_t)MP * 2 * 8); p.dbg_masks_ref = (unsigned long long*)take((size_t)MP * 2 * 8);
    p.a1ref = (bf16_t*)take((size_t)MPAD * 512 * 2);
#endif
    if (off > ws_size) { fprintf(stderr, "workspace too small: need %zu have %zu\n", off, ws_size); return; }
    static int grid_blocks = 0;
    if (!grid_blocks) {
        int dev = 0, cus = 0, per_cu = 0;
        hipGetDevice(&dev);
        hipDeviceGetAttribute(&cus, hipDeviceAttributeMultiprocessorCount, dev);
        hipFuncSetAttribute((const void*)k_mega, hipFuncAttributeMaxDynamicSharedMemorySize, LDS_BYTES);
        hipOccupancyMaxActiveBlocksPerMultiprocessor(&per_cu, k_mega, 512, LDS_BYTES);
        if (per_cu < 1) fprintf(stderr, "occupancy query reports %d blocks per CU\n", per_cu);
        grid_blocks = cus;
        if (grid_blocks > 256) grid_blocks = 256;
    }
    hipMemsetAsync(p.bar, 0, XCD_BAR_WORDS * 4 + 64, stream);
    void* args[] = {&p};
    hipError_t e = hipLaunchCooperativeKernel((void*)k_mega, dim3(grid_blocks), dim3(512), args, LDS_BYTES, stream);
    if (e != hipSuccess) fprintf(stderr, "cooperative launch failed: %s (grid %d)\n", hipGetErrorString(e), grid_blocks);
}
```
